# Optimizing an MI355X kernel written in HIP

```python
import math
import jax, jax.numpy as jnp
from jax import lax
import numpy as np

D_MODEL = 1024
BATCH = 2
SEQ = 16384
DEPTH = 2

N_META = 16
N_MIXERS = 2
N_A_LAYERS = (DEPTH + 1) // 2
N_B_LAYERS = DEPTH // 2
SC_WIDTH = 3
D_RNN = 1280
RG_BLOCKS = 10
RG_BLOCK_DIM = D_RNN // RG_BLOCKS
RG_CONV_WIDTH = 4
RG_C = 8.0
D_FF = 2816
FFN_CONV_WIDTH = 3
RMS_EPS = 1e-6

kernel_name = "hybrid_shortconv_rglru_convffn"


def rms_norm(x, g):
    xf = x.astype(jnp.float32)
    var = jnp.mean(xf * xf, axis=-1, keepdims=True)
    return (xf * lax.rsqrt(var + RMS_EPS) * g.astype(jnp.float32)).astype(x.dtype)


def causal_dwconv(x, w):
    k_width = w.shape[0]
    t_len = x.shape[1]
    xp = jnp.pad(x, ((0, 0), (k_width - 1, 0), (0, 0)))
    y = xp[:, 0:t_len] * w[0]
    for k in range(1, k_width):
        y = y + xp[:, k:k + t_len] * w[k]
    return y


def short_conv_mixer(x, w_in, conv_w, w_out):
    h = jnp.einsum('btd,de->bte', x, w_in)
    b_gate, c_gate, v = jnp.split(h, 3, axis=-1)
    u = causal_dwconv(c_gate * v, conv_w)
    return jnp.einsum('btd,de->bte', b_gate * u, w_out)


def _lin_rec_combine(left, right):
    a_l, b_l = left
    a_r, b_r = right
    return a_l * a_r, a_r * b_l + b_r


def rglru_block(x, w_in, conv_w, conv_b, w_gate_a, b_gate_a, w_gate_x, b_gate_x, lam, w_out):
    bsz, t_len, _ = x.shape
    h = jnp.einsum('btd,de->bte', x, w_in)
    g_branch, r_branch = jnp.split(h, 2, axis=-1)
    gate = jax.nn.gelu(g_branch, approximate=True)
    u = causal_dwconv(r_branch, conv_w) + conv_b
    ub = u.reshape(bsz, t_len, RG_BLOCKS, RG_BLOCK_DIM)
    r = jax.nn.sigmoid(jnp.einsum('btki,kij->btkj', ub, w_gate_a).reshape(bsz, t_len, D_RNN) + b_gate_a)
    i = jax.nn.sigmoid(jnp.einsum('btki,kij->btkj', ub, w_gate_x).reshape(bsz, t_len, D_RNN) + b_gate_x)
    log_a = -RG_C * r.astype(jnp.float32) * jax.nn.softplus(-lam.astype(jnp.float32))
    a = jnp.exp(log_a)
    mult = jnp.sqrt(-jnp.expm1(2.0 * log_a))
    b = mult * (i * u).astype(jnp.float32)
    _, hs = lax.associative_scan(_lin_rec_combine, (a, b), axis=1)
    y = hs.astype(x.dtype) * gate
    return jnp.einsum('bte,ed->btd', y, w_out)


def conv_gated_mlp(x, w_up, conv_w, w_down):
    h = jnp.einsum('btd,df->btf', x, w_up)
    h = causal_dwconv(h, conv_w)
    g, v = jnp.split(h, 2, axis=-1)
    return jnp.einsum('btf,fd->btd', jax.nn.silu(g) * v, w_down)


def setup_inputs(seed: int = 0) -> dict:
    key = jax.random.key(seed)
    ks = jax.random.split(key, 24)
    f32 = jnp.float32
    D = D_MODEL

    def nrm(k, shape, scale):
        return jax.random.normal(k, shape, f32) * scale

    x = jax.random.normal(ks[0], (BATCH, SEQ, D), f32)
    meta_tokens = nrm(ks[1], (N_META, D), 1.0)
    norm_mix_g = 1.0 + nrm(ks[2], (DEPTH, D), 0.01)
    norm_ffn_g = 1.0 + nrm(ks[3], (DEPTH, D), 0.01)
    final_norm_g = 1.0 + nrm(ks[4], (D,), 0.01)

    sc_w_in = nrm(ks[5], (N_A_LAYERS, D, 3 * D), D ** -0.5)
    sc_conv_w = nrm(ks[6], (N_A_LAYERS, SC_WIDTH, D), SC_WIDTH ** -0.5)
    sc_w_out = nrm(ks[7], (N_A_LAYERS, D, D), D ** -0.5)

    rg_w_in = nrm(ks[8], (N_B_LAYERS, D, 2 * D_RNN), D ** -0.5)
    rg_conv_w = nrm(ks[9], (N_B_LAYERS, RG_CONV_WIDTH, D_RNN), RG_CONV_WIDTH ** -0.5)
    rg_conv_b = nrm(ks[10], (N_B_LAYERS, D_RNN), 0.01)
    rg_w_gate_a = nrm(ks[11], (N_B_LAYERS, RG_BLOCKS, RG_BLOCK_DIM, RG_BLOCK_DIM), RG_BLOCK_DIM ** -0.5)
    rg_b_gate_a = nrm(ks[12], (N_B_LAYERS, D_RNN), 0.01)
    rg_w_gate_x = nrm(ks[13], (N_B_LAYERS, RG_BLOCKS, RG_BLOCK_DIM, RG_BLOCK_DIM), RG_BLOCK_DIM ** -0.5)
    rg_b_gate_x = nrm(ks[14], (N_B_LAYERS, D_RNN), 0.01)
    a_c = jax.random.uniform(ks[15], (N_B_LAYERS, D_RNN), f32, 0.9, 0.999)
    a_base = a_c ** (1.0 / RG_C)
    rg_lambda = jnp.log(a_base) - jnp.log1p(-a_base)
    rg_w_out = nrm(ks[16], (N_B_LAYERS, D_RNN, D), D_RNN ** -0.5)

    ffn_w_up = nrm(ks[17], (DEPTH, D, 2 * D_FF), D ** -0.5)
    ffn_conv_w = nrm(ks[18], (DEPTH, FFN_CONV_WIDTH, 2 * D_FF), FFN_CONV_WIDTH ** -0.5)
    ffn_w_down = nrm(ks[19], (DEPTH, D_FF, D), D_FF ** -0.5)

    return {"x": x, "meta_tokens": meta_tokens, "norm_mix_g": norm_mix_g,
            "norm_ffn_g": norm_ffn_g, "final_norm_g": final_norm_g,
            "sc_w_in": sc_w_in, "sc_conv_w": sc_conv_w, "sc_w_out": sc_w_out,
            "rg_w_in": rg_w_in, "rg_conv_w": rg_conv_w, "rg_conv_b": rg_conv_b,
            "rg_w_gate_a": rg_w_gate_a, "rg_b_gate_a": rg_b_gate_a,
            "rg_w_gate_x": rg_w_gate_x, "rg_b_gate_x": rg_b_gate_x,
            "rg_lambda": rg_lambda, "rg_w_out": rg_w_out,
            "ffn_w_up": ffn_w_up, "ffn_conv_w": ffn_conv_w, "ffn_w_down": ffn_w_down}


def reference(x, meta_tokens, norm_mix_g, norm_ffn_g, final_norm_g,
              sc_w_in, sc_conv_w, sc_w_out,
              rg_w_in, rg_conv_w, rg_conv_b, rg_w_gate_a, rg_b_gate_a,
              rg_w_gate_x, rg_b_gate_x, rg_lambda, rg_w_out,
              ffn_w_up, ffn_conv_w, ffn_w_down):
    bsz = x.shape[0]
    meta = jnp.broadcast_to(meta_tokens.astype(x.dtype)[None], (bsz, N_META, x.shape[-1]))
    h = jnp.concatenate([meta, x], axis=1)
    for layer in range(DEPTH):
        hn = rms_norm(h, norm_mix_g[layer])
        j = layer // N_MIXERS
        if layer % N_MIXERS == 0:
            mix = short_conv_mixer(hn, sc_w_in[j], sc_conv_w[j], sc_w_out[j])
        else:
            mix = rglru_block(hn, rg_w_in[j], rg_conv_w[j], rg_conv_b[j],
                              rg_w_gate_a[j], rg_b_gate_a[j], rg_w_gate_x[j], rg_b_gate_x[j],
                              rg_lambda[j], rg_w_out[j])
        h = h + mix
        h = h + conv_gated_mlp(rms_norm(h, norm_ffn_g[layer]), ffn_w_up[layer],
                               ffn_conv_w[layer], ffn_w_down[layer])
    out = rms_norm(h, final_norm_g)
    return out[:, N_META:]
```

```cpp
#include <hip/hip_runtime.h>
#include <hip/hip_cooperative_groups.h>
#include <cstdio>
#include <cstdint>
namespace cg = cooperative_groups;

#define LAS __attribute__((address_space(3)))
typedef unsigned short bf16_t;
typedef short bf16x8 __attribute__((ext_vector_type(8)));
typedef float f32x4 __attribute__((ext_vector_type(4)));
typedef unsigned u32x4 __attribute__((ext_vector_type(4)));
typedef unsigned u32x2 __attribute__((ext_vector_type(2)));
typedef float f32x2 __attribute__((ext_vector_type(2)));

constexpr int D = 1024, SEQ = 16384, NBATCH = 2, NMETA = 16;
constexpr int RT = NBATCH * SEQ;
constexpr int MROW0 = RT;
constexpr int MR = RT + NMETA;
constexpr int MPAD = 32800;
constexpr int DRNN = 1280, DFF = 2816;
constexpr float EPS = 1e-6f;
constexpr int NTHREADS = 512;

constexpr size_t MiB = 1u << 20;
constexpr size_t SS_STRIDE = 65536;
constexpr size_t WS_SS = 0;
constexpr size_t WS_SP = 1536 * 1024;
constexpr size_t WS_HMETA = 1600 * 1024;
constexpr size_t WS_FCW = 1800 * 1024;
constexpr size_t WS_CNT = 1716 * 1024;
constexpr size_t WS_BAR = 1700 * 1024;
constexpr size_t WS_AGGA = 2 * MiB, WS_AGGH = 4 * MiB, WS_CARRY = 6 * MiB;
constexpr size_t WS_PRE = 8 * MiB;
constexpr size_t WS_W = 32 * MiB;
constexpr size_t WS_HB = 84 * MiB;
constexpr size_t WS_SCR = 150 * MiB;
constexpr size_t WS_NEED = 480 * MiB;
constexpr size_t OW1 = 0, OW2 = OW1 + 3072ull * 1024, OW3 = OW2 + 1024ull * 1024, OW4 = OW3 + 5632ull * 1024, OW5 = OW4 + 1024ull * 2816,
                 OW6 = OW5 + 2560ull * 1024, OW7 = OW6 + 2560ull * 128, OW8 = OW7 + 1024ull * 1280, OW9 = OW8 + 5632ull * 1024, OWEND = OW9 + 1024ull * 2816;
static_assert(OWEND * 2 <= 52 * MiB, "weights");
constexpr size_t SCR_STRIDE = 81 * MiB;
constexpr int PRE_ROWS = 1040;

struct Params {
    const float* in[20];
    float* out;
    unsigned char* ws;
};
enum { I_X = 0, I_META, I_NMG, I_NFG, I_FNG, I_SCWIN, I_SCCONV, I_SCWOUT, I_RGWIN, I_RGCONV, I_RGCONVB, I_RGWA, I_RGBA, I_RGWX, I_RGBX, I_RGLAM, I_RGWOUT, I_FFUP, I_FFCONV, I_FFDOWN };

__device__ __forceinline__ unsigned cvt_pk_bf16(float lo, float hi) { unsigned r; asm("v_cvt_pk_bf16_f32 %0, %1, %2" : "=v"(r) : "v"(lo), "v"(hi)); return r; }
__device__ __forceinline__ float bf_lo(unsigned u) { return __uint_as_float(u << 16); }
__device__ __forceinline__ float bf_hi(unsigned u) { return __uint_as_float(u & 0xffff0000u); }
__device__ __forceinline__ u32x4 pack8(const f32x4 a, const f32x4 b) { u32x4 w; w.x = cvt_pk_bf16(a[0], a[1]); w.y = cvt_pk_bf16(a[2], a[3]); w.z = cvt_pk_bf16(b[0], b[1]); w.w = cvt_pk_bf16(b[2], b[3]); return w; }
__device__ __forceinline__ void unpack8(const u32x4 w, f32x4& a, f32x4& b) { a = (f32x4){bf_lo(w.x), bf_hi(w.x), bf_lo(w.y), bf_hi(w.y)}; b = (f32x4){bf_lo(w.z), bf_hi(w.z), bf_lo(w.w), bf_hi(w.w)}; }
__device__ __forceinline__ float fast_exp(float x) { return __builtin_amdgcn_exp2f(x * 1.44269504f); }
__device__ __forceinline__ float fast_rcp(float x) { return __builtin_amdgcn_rcpf(x); }
__device__ __forceinline__ float sigmoidf_(float x) { return fast_rcp(1.0f + fast_exp(-x)); }
__device__ __forceinline__ float siluf_(float x) { return x * sigmoidf_(x); }
__device__ __forceinline__ float gelu_tanh_(float x) { const float u = x * (-2.3022082f + -0.1029432f * (x * x)); return x * fast_rcp(1.0f + __builtin_amdgcn_exp2f(u)); }
__device__ __forceinline__ float dpp_shr1(float v) { return __int_as_float(__builtin_amdgcn_update_dpp(0, __float_as_int(v), 0x111, 0xF, 0xF, true)); }
template <int N> __device__ __forceinline__ float dpp_shr(float v, float oldv) { return __int_as_float(__builtin_amdgcn_update_dpp(__float_as_int(oldv), __float_as_int(v), 0x110 + N, 0xF, 0xF, false)); }
__device__ __forceinline__ float rs_from_ss(float ss) { return __builtin_amdgcn_rsqf(ss * (1.0f / 1024.0f) + EPS); }

namespace pg8 {
constexpr int BM = 256, BK = 64, HALF = 128, HTB = HALF * BK * 2, STAGE_BYTES = 8 * HTB, NXCD = 8, WGM = 4;
__host__ __device__ __forceinline__ int lds_byte(int r, int c) { const int st = (r >> 4) * 2 + (c >> 5), rr = r & 15, cc = c & 31, ob = rr * 64 + cc * 2; return st * 1024 + (ob ^ (((ob >> 9) & 1) << 5)); }
__host__ __device__ __forceinline__ void stage_rc(int b, int& R, int& C) { const int st = b / 1024, sb = b % 1024, swz = sb ^ (((sb >> 9) & 1) << 5); R = (st >> 1) * 16 + swz / 64; C = (st & 1) * 32 + (swz % 64) / 2; }
__host__ __device__ __forceinline__ int perm32(int rho) { const int n = rho >> 4, i = rho & 15; return 8 * (i >> 2) + 4 * n + (i & 3); }

struct Unit { int pm, pn; };
constexpr int CB_OFF = 131072 + 1024, CB_SIZE = 4096;
struct Gemm { const bf16_t* A; const bf16_t* Bt; int lda, K, a_pn_off; int ldb = 0; };

struct StaticOrder {
    int nM, nN, nwg, G, c;
    __device__ void init(int nM_, int nN_, int G_, int c_) { nM = nM_; nN = nN_; nwg = nM * nN; G = G_; c = c_; }
    __device__ bool next(int i, Unit& u) const {
        const long L = (long)i * G + c; if (L >= nwg) return false;
        int wgid = (int)L; { const int q = nwg / NXCD, r = nwg % NXCD, xcd = wgid % NXCD, off = wgid / NXCD; wgid = (xcd < r ? xcd * (q + 1) : r * (q + 1) + (xcd - r) * q) + off; }
        const int nig = WGM * nN, gid = wgid / nig, fm = gid * WGM, gsz = (nM - fm) < WGM ? (nM - fm) : WGM;
        u.pm = fm + ((wgid % nig) % gsz); u.pn = (wgid % nig) / gsz; return true;
    }
};

template <class Epi>
__device__ __forceinline__ void gemm_phase(LAS unsigned char* lds, const Gemm g, const StaticOrder& S, const Epi& E) {
    int tid = threadIdx.x; asm volatile("" : "+v"(tid));
    const int wid = __builtin_amdgcn_readfirstlane(tid >> 6), lane = tid & 63, wr = wid >> 2, wc = wid & 3, fr = lane & 15, fq = lane >> 4;
    const int K = g.K, nt = K / BK, lda = g.lda, ldb = g.ldb ? g.ldb : g.K;
    unsigned voffA[2], voffB[2];
#pragma unroll
    for (int i = 0; i < 2; ++i) { int R, C; stage_rc(tid * 16 + i * 8192, R, C); const int Rb = (R & ~31) + perm32(R & 31);
        const int Ra = Epi::TOKPERM ? (128 * (R >> 6) + 8 * (R & 15) + ((R >> 4) & 3)) : R;
        voffA[i] = (unsigned)(Ra * lda + C) * 2u; voffB[i] = (unsigned)(Rb * ldb + C) * 2u; }
    const size_t kstep = (size_t)(BK * 2);
    const size_t hA = Epi::TOKPERM ? (size_t)4 * lda * 2 : (size_t)HALF * lda * 2;
    const size_t hB = (size_t)HALF * ldb * 2;
    const size_t tA = (size_t)BM * lda * 2, tB = 2 * hB;
    const size_t apo = (size_t)g.a_pn_off * 2;
    const unsigned ldsw = (unsigned)wid * 1024u;
    const int aoff = lds_byte(wr * 64 + fr, fq * 8), boff = lds_byte(wc * 32 + fr, fq * 8);
#define PG8_SA(b, h) (((b) * 2 + (h)) * HTB)
#define PG8_SB(b, h) ((4 + (b) * 2 + (h)) * HTB)
#define PG8_STAGE(bufoff, gbase, voff) do { _Pragma("unroll") for (int _i = 0; _i < 2; ++_i) \
        __builtin_amdgcn_global_load_lds((const unsigned*)((const char*)(gbase) + (voff)[_i]), (LAS unsigned*)(lds + (bufoff) + ldsw + _i * 8192), 16, 0, 0); } while (0)
#define PG8_LDA(dst, b, h) do { _Pragma("unroll") for (int m = 0; m < 4; ++m) _Pragma("unroll") for (int k = 0; k < 2; ++k) dst[m][k] = *(const LAS bf16x8*)(lds + PG8_SA(b, h) + aoff + m * 2048 + k * 1024); } while (0)
#define PG8_LDB(dst, b, h) do { _Pragma("unroll") for (int n = 0; n < 2; ++n) _Pragma("unroll") for (int k = 0; k < 2; ++k) dst[n][k] = *(const LAS bf16x8*)(lds + PG8_SB(b, h) + boff + n * 2048 + k * 1024); } while (0)
#define PG8_MMA(ai, bj, At, Bt) do { __builtin_amdgcn_s_setprio(1); _Pragma("unroll") for (int m = 0; m < 4; ++m) _Pragma("unroll") for (int n = 0; n < 2; ++n) _Pragma("unroll") for (int k = 0; k < 2; ++k) \
        acc[ai][bj][m][n] = __builtin_amdgcn_mfma_f32_16x16x32_bf16(Bt[n][k], At[m][k], acc[ai][bj][m][n], 0, 0, 0); __builtin_amdgcn_s_setprio(0); } while (0)
#define PG8_WAIT_V(n) asm volatile("s_waitcnt vmcnt(" #n ")" ::: "memory")
#define PG8_WAIT_L(n) asm volatile("s_waitcnt lgkmcnt(" #n ")" ::: "memory")
#define PG8_BAR __builtin_amdgcn_s_barrier()
#define PG8_SCHED __builtin_amdgcn_sched_barrier(0)
    Unit cur, nxt; int ui = 0;
    if (!S.next(0, cur)) return;
    f32x4 acc[2][2][4][2];
#pragma unroll
    for (int a = 0; a < 2; ++a)
#pragma unroll
        for (int b = 0; b < 2; ++b)
#pragma unroll
            for (int m = 0; m < 4; ++m)
#pragma unroll
                for (int n = 0; n < 2; ++n) acc[a][b][m][n] = (f32x4){0.f, 0.f, 0.f, 0.f};
    bf16x8 At[4][2], B0[2][2], B1[2][2];
    const char* cA = (const char*)g.A + (size_t)cur.pm * tA + (size_t)cur.pn * apo; const char* cB = (const char*)g.Bt + (size_t)cur.pn * tB;
    E.prefetch(lds + CB_OFF, cur, wid, lane);
    PG8_STAGE(PG8_SB(0, 0), cB, voffB); PG8_STAGE(PG8_SB(0, 1), cB + hB, voffB); PG8_STAGE(PG8_SA(0, 0), cA, voffA); PG8_STAGE(PG8_SA(0, 1), cA + hA, voffA);
    if (wr == 1) PG8_BAR;
    PG8_WAIT_V(2); PG8_BAR;
    PG8_STAGE(PG8_SB(1, 0), cB + kstep, voffB); PG8_STAGE(PG8_SA(1, 0), cA + kstep, voffA); PG8_STAGE(PG8_SB(1, 1), cB + hB + kstep, voffB);
    PG8_WAIT_V(6); PG8_BAR;
    for (;;) {
        const bool has_next = S.next(ui + 1, nxt);
        const char* nA = has_next ? (const char*)g.A + (size_t)nxt.pm * tA + (size_t)nxt.pn * apo : cA; const char* nB = has_next ? (const char*)g.Bt + (size_t)nxt.pn * tB : cB;
        for (int t = 0; t < nt; t += 2) {
            const bool last = (t == nt - 2);
            const char* a1 = cA + (size_t)(t + 1) * kstep;
            const char* a2 = last ? nA : cA + (size_t)(t + 2) * kstep; const char* b2 = last ? nB : cB + (size_t)(t + 2) * kstep;
            const char* a3 = a2 + kstep; const char* b3 = b2 + kstep;
            PG8_LDB(B0, 0, 0); PG8_LDB(B1, 0, 1); PG8_SCHED; PG8_LDA(At, 0, 0); PG8_STAGE(PG8_SA(1, 1), a1 + hA, voffA);
            PG8_WAIT_V(8); PG8_WAIT_L(0); PG8_BAR; PG8_MMA(0, 0, At, B0); PG8_MMA(0, 1, At, B1); PG8_BAR; PG8_SCHED;
            PG8_LDA(At, 0, 1); PG8_STAGE(PG8_SB(0, 0), b2, voffB); PG8_STAGE(PG8_SB(0, 1), b2 + hB, voffB); PG8_STAGE(PG8_SA(0, 0), a2, voffA);
            PG8_WAIT_V(8); PG8_WAIT_L(0); PG8_BAR; PG8_MMA(1, 0, At, B0); PG8_MMA(1, 1, At, B1); PG8_BAR; PG8_SCHED;
            PG8_LDB(B0, 1, 0); PG8_LDB(B1, 1, 1); PG8_SCHED; PG8_LDA(At, 1, 0); PG8_STAGE(PG8_SA(0, 1), a2 + hA, voffA);
            PG8_WAIT_V(8); PG8_WAIT_L(0); PG8_BAR; PG8_MMA(0, 0, At, B0); PG8_MMA(0, 1, At, B1); PG8_BAR; PG8_SCHED;
            PG8_LDA(At, 1, 1); PG8_STAGE(PG8_SB(1, 0), b3, voffB); PG8_STAGE(PG8_SB(1, 1), b3 + hB, voffB); PG8_STAGE(PG8_SA(1, 0), a3, voffA);
            PG8_WAIT_V(8); PG8_WAIT_L(0); PG8_BAR; PG8_MMA(1, 0, At, B0); PG8_MMA(1, 1, At, B1); PG8_BAR; PG8_SCHED;
        }
        if constexpr (Epi::ALIGN) { if (wr == 0) PG8_BAR; }
        E.main(acc, cur, wr, wc, fr, fq, lds + CB_OFF + (ui & 1) * CB_SIZE);
        if (!has_next) break;
#pragma unroll
        for (int a = 0; a < 2; ++a)
#pragma unroll
            for (int b = 0; b < 2; ++b)
#pragma unroll
                for (int m = 0; m < 4; ++m)
#pragma unroll
                    for (int n = 0; n < 2; ++n) acc[a][b][m][n] = (f32x4){0.f, 0.f, 0.f, 0.f};
        cur = nxt; cA = nA; cB = nB; ++ui;
        E.prefetch(lds + CB_OFF + (ui & 1) * CB_SIZE, cur, wid, lane);
        if constexpr (Epi::ALIGN) { if (wr == 1) PG8_BAR; }
    }
    PG8_WAIT_V(0);
    if constexpr (!Epi::ALIGN) { if (wr == 0) PG8_BAR; }
    PG8_BAR;
#undef PG8_SA
#undef PG8_SB
#undef PG8_STAGE
#undef PG8_LDA
#undef PG8_LDB
#undef PG8_MMA
#undef PG8_WAIT_V
#undef PG8_WAIT_L
#undef PG8_BAR
#undef PG8_SCHED
}

template <class Epi>
__device__ __forceinline__ void mini_gemm(LAS unsigned char* lds, const Gemm g, int nN, const Epi& E) {
    int tid = threadIdx.x; asm volatile("" : "+v"(tid));
    const int wid = __builtin_amdgcn_readfirstlane(tid >> 6), lane = tid & 63, fr = lane & 15, fq = lane >> 4;
    const int task = (int)blockIdx.x;
    if (task >= nN * 4) return;
    const int pn = task >> 2, wc = task & 3, K = g.K;
    const int kw = (K / 32 + 7) / 8 * 32;
    const int k0 = wid * kw, k1 = (k0 + kw < K) ? k0 + kw : K;
    const bf16_t* ap = g.A + (size_t)(MROW0 + fr) * g.lda + (size_t)pn * g.a_pn_off + 8 * fq;
    const bf16_t* bp[2][2];
#pragma unroll
    for (int bj = 0; bj < 2; ++bj)
#pragma unroll
        for (int n = 0; n < 2; ++n) bp[bj][n] = g.Bt + (size_t)(256 * pn + 128 * bj + 32 * wc + 8 * (fr >> 2) + 4 * n + (fr & 3)) * K + 8 * fq;
    f32x4 acc[2][2];
#pragma unroll
    for (int bj = 0; bj < 2; ++bj)
#pragma unroll
        for (int n = 0; n < 2; ++n) acc[bj][n] = (f32x4){0.f, 0.f, 0.f, 0.f};
#pragma unroll 4
    for (int kk = k0; kk < k1; kk += 32) {
        const bf16x8 a = *(const bf16x8*)(ap + kk);
#pragma unroll
        for (int bj = 0; bj < 2; ++bj)
#pragma unroll
            for (int n = 0; n < 2; ++n) { const bf16x8 b = *(const bf16x8*)(bp[bj][n] + kk); acc[bj][n] = __builtin_amdgcn_mfma_f32_16x16x32_bf16(b, a, acc[bj][n], 0, 0, 0); }
    }
    LAS f32x4* red = (LAS f32x4*)lds;
#pragma unroll
    for (int i = 0; i < 4; ++i) red[(wid * 4 + i) * 64 + lane] = acc[i >> 1][i & 1];
    __syncthreads();
    if (wid == 0) {
#pragma unroll
        for (int w = 1; w < 8; ++w)
#pragma unroll
            for (int i = 0; i < 4; ++i) acc[i >> 1][i & 1] += red[(w * 4 + i) * 64 + lane];
        E.mini(fr, pn, wc * 32 + 8 * fq, fq, acc[0][0], acc[0][1], acc[1][0], acc[1][1]);
    }
    __syncthreads();
}
}

__device__ __forceinline__ void dma16(const float* gsrc_lane, LAS unsigned char* dst) { __builtin_amdgcn_global_load_lds((const unsigned*)gsrc_lane, (LAS unsigned*)dst, 16, 0, 0); }

template <class Epi>
__device__ __forceinline__ void epi_items(const Epi& E, f32x4 (&acc)[2][2][4][2], const pg8::Unit& u, int wr, int wc, int fr, int fq) {
#pragma unroll
    for (int ai = 0; ai < 2; ++ai)
#pragma unroll
        for (int m = 0; m < 4; ++m) {
            const int row = u.pm * 256 + ai * 128 + wr * 64 + m * 16 + fr;
            E.item(row, u.pn, wc * 32 + 8 * fq, fq, acc[ai][0][m][0], acc[ai][0][m][1], acc[ai][1][m][0], acc[ai][1][m][1]);
            asm volatile("" ::: "memory");
        }
}

struct EpiScIn {
    static constexpr bool TOKPERM = false;
    static constexpr bool ALIGN = true;
    __device__ __forceinline__ void prefetch(LAS unsigned char* cb, const pg8::Unit& u, int wid, int lane) const { if (wid == 0) dma16(SS + u.pm * 256 + lane * 4, cb); }
    const float* SS; bf16_t* CV; bf16_t* B;
    __device__ __forceinline__ void item(int row, float rs, int pn, int cw, f32x4 a0, f32x4 a1, f32x4 b0, f32x4 b1) const {
        if (pn < 8) {
            const float r2 = rs * rs;
            *(u32x4*)(CV + (size_t)row * D + pn * 128 + cw) = pack8(a0 * b0 * r2, a1 * b1 * r2);
        } else {
            bf16_t* p = B + (size_t)row * D + (pn - 8) * 256 + cw;
            *(u32x4*)p = pack8(a0 * rs, a1 * rs); *(u32x4*)(p + 128) = pack8(b0 * rs, b1 * rs);
        }
    }
    __device__ __forceinline__ void main(f32x4 (&acc)[2][2][4][2], const pg8::Unit& u, int wr, int wc, int fr, int fq, LAS unsigned char* cb) const {
        const int rbase = u.pm * 256 + wr * 64 + fr;
        const LAS float* ssl = (const LAS float*)cb + wr * 64 + fr;
        float ss[8];
#pragma unroll
        for (int i = 0; i < 8; ++i) ss[i] = ssl[(i >> 2) * 128 + (i & 3) * 16];
#pragma unroll
        for (int i = 0; i < 8; ++i) item(rbase + (i >> 2) * 128 + (i & 3) * 16, rs_from_ss(ss[i]), u.pn, wc * 32 + 8 * fq, acc[i >> 2][0][i & 3][0], acc[i >> 2][0][i & 3][1], acc[i >> 2][1][i & 3][0], acc[i >> 2][1][i & 3][1]);
    }
    __device__ __forceinline__ void mini(int mrow, int pn, int cw, int fq, f32x4 a0, f32x4 a1, f32x4 b0, f32x4 b1) const { item(MROW0 + mrow, rs_from_ss(SS[MROW0 + mrow]), pn, cw, a0, a1, b0, b1); }
};

struct EpiResid {
    static constexpr bool TOKPERM = false;
    static constexpr bool ALIGN = false;
    __device__ __forceinline__ void prefetch(LAS unsigned char*, const pg8::Unit&, int, int) const {}
    bf16_t* HB; float* SSo;
    __device__ __forceinline__ float finish(bf16_t* hb, const u32x4 r0, const u32x4 r1, f32x4 a0, f32x4 a1, f32x4 b0, f32x4 b1) const {
        f32x4 x0, x1, y0, y1; unpack8(r0, x0, x1); unpack8(r1, y0, y1);
        a0 += x0; a1 += x1; b0 += y0; b1 += y1;
        *(u32x4*)hb = pack8(a0, a1); *(u32x4*)(hb + 128) = pack8(b0, b1);
        const f32x4 q = a0 * a0 + a1 * a1 + b0 * b0 + b1 * b1;
        float sq = (q[0] + q[1]) + (q[2] + q[3]);
        sq += __shfl_xor(sq, 16); sq += __shfl_xor(sq, 32);
        return sq;
    }
    __device__ __forceinline__ void main(f32x4 (&acc)[2][2][4][2], const pg8::Unit& u, int wr, int wc, int fr, int fq, LAS unsigned char* cb) const {
        const int col = u.pn * 256 + wc * 32 + 8 * fq, rbase = u.pm * 256 + wr * 64 + fr;
        bf16_t* hb0 = HB + (size_t)rbase * D + col;
        u32x4 r[8][2];
#pragma unroll
        for (int i = 0; i < 8; ++i) { const bf16_t* q_ = hb0 + (size_t)((i >> 2) * 128 + (i & 3) * 16) * D; r[i][0] = *(const u32x4*)q_; r[i][1] = *(const u32x4*)(q_ + 128); }
#pragma unroll
        for (int ai = 0; ai < 2; ++ai) {
            float sq[4];
#pragma unroll
            for (int m = 0; m < 4; ++m) {
                const int i = ai * 4 + m, ro = ai * 128 + m * 16;
                sq[m] = finish(hb0 + (size_t)ro * D, r[i][0], r[i][1], acc[ai][0][m][0], acc[ai][0][m][1], acc[ai][1][m][0], acc[ai][1][m][1]);
            }
            const float ssel = (fq == 0) ? sq[0] : (fq == 1) ? sq[1] : (fq == 2) ? sq[2] : sq[3];
            atomicAdd(SSo + rbase + ai * 128 + fq * 16, ssel);
        }
    }
    __device__ __forceinline__ void mini(int mrow, int pn, int cw, int fq, f32x4 a0, f32x4 a1, f32x4 b0, f32x4 b1) const {
        bf16_t* hb = HB + (size_t)(MROW0 + mrow) * D + pn * 256 + cw;
        const float sq = finish(hb, *(const u32x4*)hb, *(const u32x4*)(hb + 128), a0, a1, b0, b1);
        if (fq == 0) atomicAdd(SSo + MROW0 + mrow, sq);
    }
};

struct EpiResidFinal {
    static constexpr bool TOKPERM = false;
    static constexpr bool ALIGN = true;
    __device__ __forceinline__ void prefetch(LAS unsigned char*, const pg8::Unit&, int, int) const {}
    const bf16_t* HB; float* SS; unsigned* cnt; const float* gfin; float* out;
    __device__ __forceinline__ void main(f32x4 (&acc)[2][2][4][2], const pg8::Unit& u, int wr, int wc, int fr, int fq, LAS unsigned char* cb) const {
        const int col = u.pn * 256 + wc * 32 + 8 * fq, rbase = u.pm * 256 + wr * 64 + fr;
        const bf16_t* hb0 = HB + (size_t)rbase * D + col;
        u32x4 r[8][2];
#pragma unroll
        for (int i = 0; i < 8; ++i) { const bf16_t* q_ = hb0 + (size_t)((i >> 2) * 128 + (i & 3) * 16) * D; r[i][0] = *(const u32x4*)q_; r[i][1] = *(const u32x4*)(q_ + 128); }
#pragma unroll
        for (int ai = 0; ai < 2; ++ai) {
            float sq[4];
#pragma unroll
            for (int m = 0; m < 4; ++m) {
                f32x4 x0, x1, y0, y1; unpack8(r[ai * 4 + m][0], x0, x1); unpack8(r[ai * 4 + m][1], y0, y1);
                acc[ai][0][m][0] += x0; acc[ai][0][m][1] += x1; acc[ai][1][m][0] += y0; acc[ai][1][m][1] += y1;
                const f32x4 q = acc[ai][0][m][0] * acc[ai][0][m][0] + acc[ai][0][m][1] * acc[ai][0][m][1] + acc[ai][1][m][0] * acc[ai][1][m][0] + acc[ai][1][m][1] * acc[ai][1][m][1];
                float t = (q[0] + q[1]) + (q[2] + q[3]);
                t += __shfl_xor(t, 16); t += __shfl_xor(t, 32);
                sq[m] = t;
            }
            const float ssel = (fq == 0) ? sq[0] : (fq == 1) ? sq[1] : (fq == 2) ? sq[2] : sq[3];
            atomicAdd(SS + rbase + ai * 128 + fq * 16, ssel);
        }
        asm volatile("s_waitcnt vmcnt(0)" ::: "memory");
        unsigned* pc = cnt + 64 * u.pm;
        if ((threadIdx.x & 63) == 0) (void)__hip_atomic_fetch_add(pc, 1u, __ATOMIC_RELAXED, __HIP_MEMORY_SCOPE_AGENT);
        { unsigned sp = 0;
          while ((unsigned)__builtin_amdgcn_readfirstlane(__hip_atomic_load(pc, __ATOMIC_RELAXED, __HIP_MEMORY_SCOPE_AGENT)) < 32u) { __builtin_amdgcn_s_sleep(1); if (++sp > (1u << 20)) break; } }
        const f32x4 g00 = *(const f32x4*)(gfin + col), g01 = *(const f32x4*)(gfin + col + 4), g10 = *(const f32x4*)(gfin + col + 128), g11 = *(const f32x4*)(gfin + col + 132);
#pragma unroll
        for (int ai = 0; ai < 2; ++ai)
#pragma unroll
            for (int m = 0; m < 4; ++m) {
                const int row = rbase + ai * 128 + m * 16;
                const float rs = rs_from_ss(__hip_atomic_load(SS + row, __ATOMIC_RELAXED, __HIP_MEMORY_SCOPE_AGENT));
                float* o = out + (size_t)row * D + col;
                *(f32x4*)o = acc[ai][0][m][0] * rs * g00; *(f32x4*)(o + 4) = acc[ai][0][m][1] * rs * g01;
                *(f32x4*)(o + 128) = acc[ai][1][m][0] * rs * g10; *(f32x4*)(o + 132) = acc[ai][1][m][1] * rs * g11;
            }
    }
};

struct EpiFfnUp {
    static constexpr bool TOKPERM = true;
    static constexpr bool ALIGN = true;
    __device__ __forceinline__ void prefetch(LAS unsigned char* cb, const pg8::Unit& u, int wid, int lane) const {
        if (wid == 0) dma16(SS + u.pm * 256 + lane * 4, cb);
        else if (wid < 4) { const int k6 = 2 * (wid - 1) + (lane >> 5); dma16(cw_ + k6 * DFF + u.pn * 128 + (lane & 31) * 4, cb + 1024 + (wid - 1) * 1024); }
    }
    const float* SS; const float* cw_;
    bf16_t* ACT; float* PRE;
    __device__ __forceinline__ void main(f32x4 (&acc)[2][2][4][2], const pg8::Unit& u, int wr, int wc, int fr, int fq, LAS unsigned char* cb) const {
        const int tok0 = u.pm * 256 + wr * 128 + fr * 8;
        const int chb = u.pn * 128 + wc * 32 + fq * 8;
        const f32x4 s0 = *(const LAS f32x4*)(cb + (wr * 128 + fr * 8) * 4), s1 = *(const LAS f32x4*)(cb + (wr * 128 + fr * 8 + 4) * 4);
        f32x4 cwv[2][6];
#pragma unroll
        for (int n = 0; n < 2; ++n)
#pragma unroll
            for (int k6 = 0; k6 < 6; ++k6) cwv[n][k6] = *(const LAS f32x4*)(cb + 1024 + k6 * 512 + (wc * 32 + fq * 8 + 4 * n) * 4);
#pragma unroll
        for (int m = 0; m < 4; ++m) {
            const float r0 = rs_from_ss(s0[m]), r1 = rs_from_ss(s1[m]);
#pragma unroll
            for (int bj = 0; bj < 2; ++bj)
#pragma unroll
                for (int n = 0; n < 2; ++n) { acc[0][bj][m][n] *= r0; acc[1][bj][m][n] *= r1; }
        }
        const int grp = u.pm * 2 + wr;
        if (fr == 0 || fr == 15) {
            const bool lo = (fr == 0);
            bf16_t* P16 = (bf16_t*)PRE;
#pragma unroll
            for (int j = 0; j < 2; ++j) {
                const f32x4 g0 = lo ? acc[0][0][j][0] : acc[1][0][2 + j][0], g1 = lo ? acc[0][0][j][1] : acc[1][0][2 + j][1];
                const f32x4 v0 = lo ? acc[0][1][j][0] : acc[1][1][2 + j][0], v1 = lo ? acc[0][1][j][1] : acc[1][1][2 + j][1];
                bf16_t* p = P16 + (size_t)(4 * grp + (lo ? 0 : 2) + j) * (2 * DFF) + chb;
                *(u32x4*)p = pack8(g0, g1); *(u32x4*)(p + DFF) = pack8(v0, v1);
            }
        }
        f32x4 hg[2][2], hv[2][2];
#pragma unroll
        for (int n = 0; n < 2; ++n)
#pragma unroll
            for (int e = 0; e < 4; ++e) {
                hg[0][n][e] = dpp_shr1(acc[1][0][2][n][e]); hg[1][n][e] = dpp_shr1(acc[1][0][3][n][e]);
                hv[0][n][e] = dpp_shr1(acc[1][1][2][n][e]); hv[1][n][e] = dpp_shr1(acc[1][1][3][n][e]);
            }
#pragma unroll
        for (int j = 0; j < 8; ++j) {
            f32x4 res[2];
#pragma unroll
            for (int n = 0; n < 2; ++n) {
                const f32x4 g0 = acc[j >> 2][0][j & 3][n], v0 = acc[j >> 2][1][j & 3][n];
                const f32x4 g1 = (j >= 1) ? acc[(j - 1) >> 2][0][(j - 1) & 3][n] : hg[1][n], v1 = (j >= 1) ? acc[(j - 1) >> 2][1][(j - 1) & 3][n] : hv[1][n];
                const f32x4 g2 = (j >= 2) ? acc[(j - 2) >> 2][0][(j - 2) & 3][n] : hg[j][n], v2 = (j >= 2) ? acc[(j - 2) >> 2][1][(j - 2) & 3][n] : hv[j][n];
                const f32x4 yg = cwv[n][0] * g2 + cwv[n][2] * g1 + cwv[n][4] * g0;
                const f32x4 yv = cwv[n][1] * v2 + cwv[n][3] * v1 + cwv[n][5] * v0;
                f32x4 ex;
#pragma unroll
                for (int e = 0; e < 4; ++e) ex[e] = __builtin_amdgcn_exp2f(yg[e]);
                const f32x4 dn = ex + 1.0f;
                f32x4 rc;
#pragma unroll
                for (int e = 0; e < 4; ++e) rc[e] = fast_rcp(dn[e]);
                res[n] = (yg * rc) * yv;
            }
            if (!(fr == 0 && j < 2)) __builtin_nontemporal_store(pack8(res[0], res[1]), (u32x4*)(ACT + (size_t)(tok0 + j) * DFF + chb));
        }
    }
    __device__ __forceinline__ void mini(int mrow, int pn, int cw, int fq, f32x4 a0, f32x4 a1, f32x4 b0, f32x4 b1) const {
        const float rs = rs_from_ss(SS[MROW0 + mrow]);
        bf16_t* p = (bf16_t*)PRE + (size_t)(1024 + mrow) * (2 * DFF) + pn * 128 + cw;
        *(u32x4*)p = pack8(a0 * rs, a1 * rs); *(u32x4*)(p + DFF) = pack8(b0 * rs, b1 * rs);
    }
};

struct EpiRgIn {
    static constexpr bool TOKPERM = true;
    static constexpr bool ALIGN = true;
    __device__ __forceinline__ void prefetch(LAS unsigned char* cb, const pg8::Unit& u, int wid, int lane) const {
        if (wid == 0) dma16(SS + u.pm * 256 + lane * 4, cb);
        else if (wid < 4) { int k = 2 * (wid - 1) + (lane >> 5); k = k > 4 ? 4 : k; const float* src = (k < 4) ? cw_ + k * DRNN : cb_; dma16(src + u.pn * 128 + (lane & 31) * 4, cb + 1024 + (wid - 1) * 1024); }
    }
    const float* SS; const float* cw_; const float* cb_;
    bf16_t* GATE; bf16_t* U; float* PRE;
    __device__ __forceinline__ void main(f32x4 (&acc)[2][2][4][2], const pg8::Unit& u, int wr, int wc, int fr, int fq, LAS unsigned char* cb) const {
        const int tok0 = u.pm * 256 + wr * 128 + fr * 8;
        const int chb = u.pn * 128 + wc * 32 + fq * 8;
        const f32x4 s0 = *(const LAS f32x4*)(cb + (wr * 128 + fr * 8) * 4), s1 = *(const LAS f32x4*)(cb + (wr * 128 + fr * 8 + 4) * 4);
        f32x4 cwv[2][5];
#pragma unroll
        for (int n = 0; n < 2; ++n)
#pragma unroll
            for (int k = 0; k < 5; ++k) cwv[n][k] = *(const LAS f32x4*)(cb + 1024 + k * 512 + (wc * 32 + fq * 8 + 4 * n) * 4);
#pragma unroll
        for (int m = 0; m < 4; ++m) {
            const float r0 = rs_from_ss(s0[m]), r1 = rs_from_ss(s1[m]);
#pragma unroll
            for (int bj = 0; bj < 2; ++bj)
#pragma unroll
                for (int n = 0; n < 2; ++n) { acc[0][bj][m][n] *= r0; acc[1][bj][m][n] *= r1; }
        }
#pragma unroll
        for (int j = 0; j < 8; ++j) {
            f32x4 a0 = acc[j >> 2][0][j & 3][0], a1 = acc[j >> 2][0][j & 3][1];
#pragma unroll
            for (int e = 0; e < 4; ++e) { a0[e] = gelu_tanh_(a0[e]); a1[e] = gelu_tanh_(a1[e]); }
            __builtin_nontemporal_store(pack8(a0, a1), (u32x4*)(GATE + (size_t)(tok0 + j) * DRNN + chb));
        }
        const int grp = u.pm * 2 + wr;
        if (fr == 0 || fr == 15) {
            const bool lo = (fr == 0);
            bf16_t* P16 = (bf16_t*)PRE;
#pragma unroll
            for (int j = 0; j < 3; ++j) {
                const f32x4 x0 = lo ? acc[0][1][j][0] : acc[1][1][1 + j][0], x1 = lo ? acc[0][1][j][1] : acc[1][1][1 + j][1];
                *(u32x4*)(P16 + (size_t)(6 * grp + (lo ? 0 : 3) + j) * DRNN + chb) = pack8(x0, x1);
            }
        }
#pragma unroll
        for (int n = 0; n < 2; ++n)
#pragma unroll
            for (int e = 0; e < 4; ++e) {
                const float pm1 = dpp_shr1(acc[1][1][3][n][e]), pm2 = dpp_shr1(acc[1][1][2][n][e]), pm3 = dpp_shr1(acc[1][1][1][n][e]);
                const float w0 = cwv[n][0][e], w1 = cwv[n][1][e], w2 = cwv[n][2][e], w3 = cwv[n][3][e], bs = cwv[n][4][e];
#pragma unroll
                for (int j = 7; j >= 0; --j) {
                    const float x0 = acc[j >> 2][1][j & 3][n][e];
                    const float x1 = (j >= 1) ? acc[(j - 1) >> 2][1][(j - 1) & 3][n][e] : pm1;
                    const float x2 = (j >= 2) ? acc[(j - 2) >> 2][1][(j - 2) & 3][n][e] : (j == 1 ? pm1 : pm2);
                    const float x3 = (j >= 3) ? acc[(j - 3) >> 2][1][(j - 3) & 3][n][e] : (j == 2 ? pm1 : (j == 1 ? pm2 : pm3));
                    acc[j >> 2][1][j & 3][n][e] = bs + w0 * x3 + w1 * x2 + w2 * x1 + w3 * x0;
                }
            }
#pragma unroll
        for (int j = 0; j < 8; ++j)
            if (!(fr == 0 && j < 3)) *(u32x4*)(U + (size_t)(tok0 + j) * DRNN + chb) = pack8(acc[j >> 2][1][j & 3][0], acc[j >> 2][1][j & 3][1]);
    }
    __device__ __forceinline__ void mini(int mrow, int pn, int cw, int fq, f32x4 a0, f32x4 a1, f32x4 b0, f32x4 b1) const {
        const float rs = rs_from_ss(SS[MROW0 + mrow]);
        a0 *= rs; a1 *= rs;
#pragma unroll
        for (int e = 0; e < 4; ++e) { a0[e] = gelu_tanh_(a0[e]); a1[e] = gelu_tanh_(a1[e]); }
        *(u32x4*)(GATE + (size_t)(MROW0 + mrow) * DRNN + pn * 128 + cw) = pack8(a0, a1);
        *(u32x4*)((bf16_t*)PRE + (size_t)(1536 + mrow) * DRNN + pn * 128 + cw) = pack8(b0 * rs, b1 * rs);
    }
};

struct EpiRgGate {
    static constexpr bool TOKPERM = true;
    static constexpr bool ALIGN = true;
    __device__ __forceinline__ void prefetch(LAS unsigned char*, const pg8::Unit&, int, int) const {}
    const bf16_t* U; const float* ba; const float* bx; const float* SP; bf16_t* HL; bf16_t* AC; float* AGGA; float* AGGH;
    __device__ __forceinline__ void ab(float pa, float px, float vba, float vbx, float vsp, float u, float& a, float& b) const {
        const float r = sigmoidf_(pa + vba), ig = sigmoidf_(px + vbx); const float la = -r * vsp;
        a = fast_exp(la); const float om = (1.0f - a) * (1.0f + a); b = __builtin_amdgcn_sqrtf(om) * ig * u;
    }
    __device__ __forceinline__ void main(f32x4 (&acc)[2][2][4][2], const pg8::Unit& u, int wr, int wc, int fr, int fq, LAS unsigned char* cb) const {
        const int tok0 = u.pm * 256 + wr * 128 + fr * 8;
        const int ch = u.pn * 128 + wc * 32 + fq * 8;
        const int grp = u.pm * 2 + wr;
        u32x4 ur[8];
#pragma unroll
        for (int j = 0; j < 8; ++j) ur[j] = *(const u32x4*)(U + (size_t)(tok0 + j) * DRNN + ch);
        f32x4 kc[2][3];
#pragma unroll
        for (int n = 0; n < 2; ++n) { kc[n][0] = *(const f32x4*)(ba + ch + 4 * n); kc[n][1] = *(const f32x4*)(bx + ch + 4 * n); kc[n][2] = *(const f32x4*)(SP + ch + 4 * n); }
#pragma unroll
        for (int n = 0; n < 2; ++n) {
            const f32x4 vba = kc[n][0], vbx = kc[n][1], vsp = kc[n][2];
            f32x4 aggA, aggH;
#pragma unroll
            for (int e = 0; e < 4; ++e) {
                float cA = 1.f, cH = 0.f;
#pragma unroll
                for (int j = 0; j < 8; ++j) {
                    const unsigned uw = (n == 0) ? ((e < 2) ? ur[j].x : ur[j].y) : ((e < 2) ? ur[j].z : ur[j].w);
                    const float uu = (e & 1) ? bf_hi(uw) : bf_lo(uw);
                    float a, b; ab(acc[j >> 2][0][j & 3][n][e], acc[j >> 2][1][j & 3][n][e], vba[e], vbx[e], vsp[e], uu, a, b);
                    cH = a * cH + b; cA = a * cA;
                    acc[j >> 2][0][j & 3][n][e] = cH; acc[j >> 2][1][j & 3][n][e] = cA;
                }
                float A = cA, H = cH;
                { const float Ap = dpp_shr<1>(A, 1.f), Hp = dpp_shr<1>(H, 0.f); H = A * Hp + H; A = A * Ap; }
                { const float Ap = dpp_shr<2>(A, 1.f), Hp = dpp_shr<2>(H, 0.f); H = A * Hp + H; A = A * Ap; }
                { const float Ap = dpp_shr<4>(A, 1.f), Hp = dpp_shr<4>(H, 0.f); H = A * Hp + H; A = A * Ap; }
                { const float Ap = dpp_shr<8>(A, 1.f), Hp = dpp_shr<8>(H, 0.f); H = A * Hp + H; A = A * Ap; }
                aggA[e] = A; aggH[e] = H;
                const float Aex = dpp_shr<1>(A, 1.f), Hex = dpp_shr<1>(H, 0.f);
#pragma unroll
                for (int j = 0; j < 8; ++j) {
                    const float hl = acc[j >> 2][0][j & 3][n][e], ac = acc[j >> 2][1][j & 3][n][e];
                    acc[j >> 2][0][j & 3][n][e] = hl + ac * Hex; acc[j >> 2][1][j & 3][n][e] = ac * Aex;
                }
            }
            if (fr == 15) { *(f32x4*)(AGGA + (size_t)grp * DRNN + ch + 4 * n) = aggA; *(f32x4*)(AGGH + (size_t)grp * DRNN + ch + 4 * n) = aggH; }
        }
#pragma unroll
        for (int j = 0; j < 8; ++j) {
            const size_t o = (size_t)(tok0 + j) * DRNN + ch;
            *(u32x4*)(HL + o) = pack8(acc[j >> 2][0][j & 3][0], acc[j >> 2][0][j & 3][1]);
            *(u32x4*)(AC + o) = pack8(acc[j >> 2][1][j & 3][0], acc[j >> 2][1][j & 3][1]);
        }
    }
    __device__ __forceinline__ void mini(int mrow, int pn, int cw, int fq, f32x4 a0, f32x4 a1, f32x4 b0, f32x4 b1) const {
        const int ch = pn * 128 + cw; const size_t o = (size_t)(MROW0 + mrow) * DRNN + ch;
        f32x4 u0, u1; unpack8(*(const u32x4*)(U + o), u0, u1);
        f32x4 hl[2], ac[2];
#pragma unroll
        for (int n = 0; n < 2; ++n) {
            const f32x4 vba = *(const f32x4*)(ba + ch + 4 * n), vbx = *(const f32x4*)(bx + ch + 4 * n), vsp = *(const f32x4*)(SP + ch + 4 * n);
#pragma unroll
            for (int e = 0; e < 4; ++e) {
                float A, H; ab(n ? a1[e] : a0[e], n ? b1[e] : b0[e], vba[e], vbx[e], vsp[e], n ? u1[e] : u0[e], A, H);
                { const float Ap = dpp_shr<1>(A, 1.f), Hp = dpp_shr<1>(H, 0.f); H = A * Hp + H; A = A * Ap; }
                { const float Ap = dpp_shr<2>(A, 1.f), Hp = dpp_shr<2>(H, 0.f); H = A * Hp + H; A = A * Ap; }
                { const float Ap = dpp_shr<4>(A, 1.f), Hp = dpp_shr<4>(H, 0.f); H = A * Hp + H; A = A * Ap; }
                { const float Ap = dpp_shr<8>(A, 1.f), Hp = dpp_shr<8>(H, 0.f); H = A * Hp + H; A = A * Ap; }
                hl[n][e] = H; ac[n][e] = A;
            }
            if (mrow == 15) { *(f32x4*)(AGGA + (size_t)256 * DRNN + ch + 4 * n) = ac[n]; *(f32x4*)(AGGH + (size_t)256 * DRNN + ch + 4 * n) = hl[n]; }
        }
        *(u32x4*)(HL + o) = pack8(hl[0], hl[1]);
        *(u32x4*)(AC + o) = pack8(ac[0], ac[1]);
    }
};

struct Ctx { int tid, gtid, gthreads, G, wid, lane; };
__device__ __forceinline__ Ctx mkctx() { Ctx c; int t = threadIdx.x; asm volatile("" : "+v"(t)); c.tid = t; c.G = gridDim.x; c.gtid = blockIdx.x * NTHREADS + t; c.gthreads = c.G * NTHREADS;
    c.wid = __builtin_amdgcn_readfirstlane(t >> 6); c.lane = t & 63; return c; }

__device__ __forceinline__ void wjob(const Params& p, int job, int q, const float*& src, const float*& gain, bf16_t*& dst, int& K, int& Nsrc, int& col0) {
    bf16_t* W = (bf16_t*)(p.ws + WS_W);
    gain = nullptr;
    switch (job) {
    case 0: src = p.in[I_SCWIN]; gain = p.in[I_NMG]; dst = W + OW1; K = 1024; Nsrc = 3072; col0 = (q < 16) ? (((q & 1) ? 2048 : 1024) + 128 * (q >> 1)) : 128 * (q - 16); break;
    case 1: src = p.in[I_SCWOUT]; dst = W + OW2; K = 1024; Nsrc = 1024; col0 = 128 * q; break;
    case 2: src = p.in[I_FFUP]; gain = p.in[I_NFG]; dst = W + OW3; K = 1024; Nsrc = 5632; col0 = ((q & 1) ? DFF : 0) + 128 * (q >> 1); break;
    case 3: src = p.in[I_FFDOWN]; dst = W + OW4; K = 2816; Nsrc = 1024; col0 = 128 * q; break;
    case 4: src = p.in[I_RGWIN]; gain = p.in[I_NMG] + 1024; dst = W + OW5; K = 1024; Nsrc = 2560; col0 = ((q & 1) ? DRNN : 0) + 128 * (q >> 1); break;
    case 5: src = p.in[I_RGWOUT]; dst = W + OW7; K = 1280; Nsrc = 1024; col0 = 128 * q; break;
    case 6: src = p.in[I_FFUP] + (size_t)1024 * 5632; gain = p.in[I_NFG] + 1024; dst = W + OW8; K = 1024; Nsrc = 5632; col0 = ((q & 1) ? DFF : 0) + 128 * (q >> 1); break;
    case 7: src = p.in[I_FFDOWN] + (size_t)2816 * 1024; dst = W + OW9; K = 2816; Nsrc = 1024; col0 = 128 * q; break;
    default: src = ((q & 1) ? p.in[I_RGWX] : p.in[I_RGWA]) + (size_t)(q >> 1) * 16384; dst = W + OW6; K = 128; Nsrc = 128; col0 = 0; break;
    }
}
__device__ __forceinline__ void prep_phase(const Params& p, LAS unsigned char* lds) {
    const Ctx c = mkctx();
    float* SS = (float*)(p.ws + WS_SS);
    for (int i = c.gtid; i < 4 * (int)SS_STRIDE; i += c.gthreads) SS[SS_STRIDE + i] = 0.f;
    { float* FCW = (float*)(p.ws + WS_FCW); const float* fw = p.in[I_FFCONV];
      for (int i = c.gtid; i < 2 * 3 * 2 * DFF; i += c.gthreads) FCW[i] = fw[i] * (((i % (2 * DFF)) < DFF) ? -1.44269504f : -0.69314718f); }
    { float* SP = (float*)(p.ws + WS_SP); const float* lam = p.in[I_RGLAM];
      for (int i = c.gtid; i < DRNN; i += c.gthreads) SP[i] = 8.0f * log1pf(expf(-lam[i])); }
    { bf16_t* HB = (bf16_t*)(p.ws + WS_HB);
      for (int r0 = (blockIdx.x * 8 + c.wid) * 4; r0 < MR; r0 += c.G * 32) {
          f32x4 a[4][2], b[4][2];
#pragma unroll
          for (int k = 0; k < 4; ++k) { const int row = r0 + k;
              const float* src = (row < RT) ? p.in[I_X] + (size_t)row * D : p.in[I_META] + (size_t)(row - RT) * D;
#pragma unroll
              for (int i = 0; i < 2; ++i) { const int col = i * 512 + c.lane * 8; a[k][i] = __builtin_nontemporal_load((const f32x4*)(src + col)); b[k][i] = __builtin_nontemporal_load((const f32x4*)(src + col + 4)); } }
#pragma unroll
          for (int k = 0; k < 4; ++k) { const int row = r0 + k; float s = 0.f;
#pragma unroll
              for (int i = 0; i < 2; ++i) { const int col = i * 512 + c.lane * 8; const f32x4 q = a[k][i] * a[k][i] + b[k][i] * b[k][i]; s += (q[0] + q[1]) + (q[2] + q[3]);
                  *(u32x4*)(HB + (size_t)row * D + col) = pack8(a[k][i], b[k][i]); }
#pragma unroll
              for (int o = 32; o >= 1; o >>= 1) s += __shfl_xor(s, o);
              if (c.lane == 0) SS[row] = s; }
      } }
    LAS bf16_t* T = (LAS bf16_t*)lds;
    const int j4 = (c.tid & 31) * 4, kp = c.tid >> 5;
    f32x4 va[2][2];
    bf16_t* dstc = nullptr; int Kc = 0, qc = 0, kbc = 0;
#define WITEM_DECODE(it_, job_, q_, kb_) do { int base_ = 0; job_ = 0; \
        if (it_ >= 384) { ++job_; base_ = 384; } if (it_ >= 512) { ++job_; base_ = 512; } if (it_ >= 1216) { ++job_; base_ = 1216; } if (it_ >= 1568) { ++job_; base_ = 1568; } \
        if (it_ >= 1888) { ++job_; base_ = 1888; } if (it_ >= 2048) { ++job_; base_ = 2048; } if (it_ >= 2752) { ++job_; base_ = 2752; } if (it_ >= 3104) { ++job_; base_ = 3104; } \
        const int li_ = it_ - base_; const int Kj_ = (job_ == 3 || job_ == 7) ? 2816 : (job_ == 5 ? 1280 : (job_ == 8 ? 128 : 1024)); const int nkb_ = Kj_ / 64; q_ = li_ / nkb_; kb_ = li_ % nkb_; } while (0)
#define WITEM_LOAD(it_, vv, dst_, K_, q_, kb_) do { int job_; WITEM_DECODE(it_, job_, q_, kb_); const float* src_; const float* gain_; int Nsrc_, col0_; \
        wjob(p, job_, q_, src_, gain_, dst_, K_, Nsrc_, col0_); \
        _Pragma("unroll") for (int ps = 0; ps < 2; ++ps) { const int k_ = kb_ * 64 + 2 * (kp + 16 * ps); \
            vv[ps][0] = __builtin_nontemporal_load((const f32x4*)(src_ + (size_t)k_ * Nsrc_ + col0_ + j4)); vv[ps][1] = __builtin_nontemporal_load((const f32x4*)(src_ + (size_t)(k_ + 1) * Nsrc_ + col0_ + j4)); \
            if (gain_) { vv[ps][0] *= gain_[k_]; vv[ps][1] *= gain_[k_ + 1]; } } } while (0)
    int it = blockIdx.x;
    if (it < 3144) WITEM_LOAD(it, va, dstc, Kc, qc, kbc);
    for (; it < 3144; it += c.G) {
        f32x4 vb[2][2]; bf16_t* dstn = nullptr; int Kn = 0, qn = 0, kbn = 0;
        const int nx = it + c.G;
        if (nx < 3144) WITEM_LOAD(nx, vb, dstn, Kn, qn, kbn);
        {
            LAS unsigned* T32 = (LAS unsigned*)T;
#pragma unroll
            for (int ps = 0; ps < 2; ++ps) { const int x = kp + 16 * ps;
#pragma unroll
                for (int e = 0; e < 4; ++e) { const int j = j4 + e; T32[j * 36 + (x ^ (((j >> 2) & 7) << 2))] = cvt_pk_bf16(va[ps][0][e], va[ps][1][e]); } }
        }
        __syncthreads();
        {
            const int jr = c.tid >> 3, seg = c.tid & 7;
            const LAS unsigned* T32 = (const LAS unsigned*)T;
#pragma unroll
            for (int ps = 0; ps < 2; ++ps) {
                const int j = jr + 64 * ps;
                const u32x4 w = *(const LAS u32x4*)(T32 + j * 36 + ((4 * seg) ^ (((j >> 2) & 7) << 2)));
                *(u32x4*)(dstc + (size_t)(128 * qc + j) * Kc + kbc * 64 + seg * 8) = w;
            }
        }
        __syncthreads();
#pragma unroll
        for (int ps = 0; ps < 2; ++ps) { va[ps][0] = vb[ps][0]; va[ps][1] = vb[ps][1]; }
        dstc = dstn; Kc = Kn; qc = qn; kbc = kbn;
    }
#undef WITEM_LOAD
#undef WITEM_DECODE
}

template <int KW, bool GATE, bool BIAS>
__device__ __forceinline__ void conv_pass(const bf16_t* X, const bf16_t* Bg, bf16_t* Y, const float* w, const float* bias, int C) {
    const Ctx c = mkctx();
    const int ncg = C / 8, nchunks = MR / 16, total = ncg * nchunks;
    for (int it = c.gtid; it < total; it += c.gthreads) {
        const int ck = it / ncg, cgp = it % ncg, ch = cgp * 8, row0 = ck * 16;
        f32x4 wa[KW], wb[KW];
#pragma unroll
        for (int k = 0; k < KW; ++k) { wa[k] = *(const f32x4*)(w + (size_t)k * C + ch); wb[k] = *(const f32x4*)(w + (size_t)k * C + ch + 4); }
        f32x4 bsa = (f32x4){0.f, 0.f, 0.f, 0.f}, bsb = bsa;
        if (BIAS) { bsa = *(const f32x4*)(bias + ch); bsb = *(const f32x4*)(bias + ch + 4); }
        f32x4 ha[KW - 1], hb[KW - 1];
        const bool ismeta = (ck == nchunks - 1);
        const bool bstart = (!ismeta) && ((row0 & (SEQ - 1)) == 0);
#pragma unroll
        for (int k = 0; k < KW - 1; ++k) {
            if (ismeta) { ha[k] = (f32x4){0.f, 0.f, 0.f, 0.f}; hb[k] = ha[k]; }
            else { const int pr = bstart ? (MROW0 + NMETA - (KW - 1) + k) : (row0 - (KW - 1) + k);
                   unpack8(*(const u32x4*)(X + (size_t)pr * C + ch), ha[k], hb[k]); }
        }
#pragma unroll
        for (int r = 0; r < 16; ++r) {
            f32x4 xa, xb; unpack8(__builtin_nontemporal_load((const u32x4*)(X + (size_t)(row0 + r) * C + ch)), xa, xb);
            f32x4 ya = wa[KW - 1] * xa + bsa, yb = wb[KW - 1] * xb + bsb;
#pragma unroll
            for (int k = 0; k < KW - 1; ++k) { ya += wa[k] * ha[k]; yb += wb[k] * hb[k]; }
#pragma unroll
            for (int k = 0; k < KW - 2; ++k) { ha[k] = ha[k + 1]; hb[k] = hb[k + 1]; }
            ha[KW - 2] = xa; hb[KW - 2] = xb;
            if (GATE) { f32x4 ga, gb; unpack8(__builtin_nontemporal_load((const u32x4*)(Bg + (size_t)(row0 + r) * C + ch)), ga, gb); ya *= ga; yb *= gb; }
            *(u32x4*)(Y + (size_t)(row0 + r) * C + ch) = pack8(ya, yb);
        }
    }
}

__device__ __forceinline__ void ffn_fixup(const float* PRE, const float* cw_, bf16_t* ACT) {
    const Ctx c = mkctx();
    const int ncg = DFF / 8, total = 528 * ncg;
    for (int it = c.gtid; it < total; it += c.gthreads) {
        const int rid = it / ncg, ch = (it % ncg) * 8;
        int r0, r1, r2, orow;
        if (rid < 512) {
            const int G = rid >> 1, j = rid & 1;
            const int pl0 = ((G & 127) == 0) ? 1024 + 14 : 4 * (G - 1) + 2, pl1 = pl0 + 1;
            if (j == 0) { r0 = pl0; r1 = pl1; r2 = 4 * G; } else { r0 = pl1; r1 = 4 * G; r2 = 4 * G + 1; }
            orow = 128 * G + j;
        } else {
            const int m = rid - 512; r2 = 1024 + m; r1 = (m >= 1) ? 1024 + m - 1 : -1; r0 = (m >= 2) ? 1024 + m - 2 : -1; orow = MROW0 + m;
        }
        f32x4 y[2][2];
        const bf16_t* P16 = (const bf16_t*)PRE;
#pragma unroll
        for (int hv = 0; hv < 2; ++hv) {
            const int col = hv * DFF + ch;
            const f32x4 z = (f32x4){0.f, 0.f, 0.f, 0.f};
            f32x4 x0a = z, x0b = z, x1a = z, x1b = z, x2a, x2b;
            if (r0 >= 0) unpack8(*(const u32x4*)(P16 + (size_t)r0 * (2 * DFF) + col), x0a, x0b);
            if (r1 >= 0) unpack8(*(const u32x4*)(P16 + (size_t)r1 * (2 * DFF) + col), x1a, x1b);
            unpack8(*(const u32x4*)(P16 + (size_t)r2 * (2 * DFF) + col), x2a, x2b);
            y[hv][0] = *(const f32x4*)(cw_ + col) * x0a + *(const f32x4*)(cw_ + 2 * DFF + col) * x1a + *(const f32x4*)(cw_ + 4 * DFF + col) * x2a;
            y[hv][1] = *(const f32x4*)(cw_ + col + 4) * x0b + *(const f32x4*)(cw_ + 2 * DFF + col + 4) * x1b + *(const f32x4*)(cw_ + 4 * DFF + col + 4) * x2b;
        }
#pragma unroll
        for (int n = 0; n < 2; ++n)
#pragma unroll
            for (int e = 0; e < 4; ++e) y[0][n][e] = siluf_(y[0][n][e]) * y[1][n][e];
        *(u32x4*)(ACT + (size_t)orow * DFF + ch) = pack8(y[0][0], y[0][1]);
    }
}

__device__ __forceinline__ void rg_fixup(const float* PRE, const float* cw_, const float* cb_, bf16_t* U) {
    const Ctx c = mkctx();
    const int ncg = DRNN / 8, total = 784 * ncg;
    for (int it = c.gtid; it < total; it += c.gthreads) {
        const int rid = it / ncg, ch = (it % ncg) * 8;
        int rr[4], orow;
        if (rid < 768) {
            const int G = rid / 3, j = rid % 3;
            const int pl = ((G & 127) == 0) ? 1536 + 13 : 6 * (G - 1) + 3;
#pragma unroll
            for (int k = 0; k < 4; ++k) { const int q = j + k; rr[k] = (q < 3) ? pl + q : 6 * G + (q - 3); }
            orow = 128 * G + j;
        } else {
            const int m = rid - 768;
#pragma unroll
            for (int k = 0; k < 4; ++k) { const int q = m - 3 + k; rr[k] = (q >= 0) ? 1536 + q : -1; }
            orow = MROW0 + m;
        }
        f32x4 y[2];
        y[0] = *(const f32x4*)(cb_ + ch); y[1] = *(const f32x4*)(cb_ + ch + 4);
        const bf16_t* P16 = (const bf16_t*)PRE;
#pragma unroll
        for (int k = 0; k < 4; ++k) {
            if (rr[k] >= 0) { f32x4 xa, xb; unpack8(*(const u32x4*)(P16 + (size_t)rr[k] * DRNN + ch), xa, xb);
                y[0] += *(const f32x4*)(cw_ + k * DRNN + ch) * xa; y[1] += *(const f32x4*)(cw_ + k * DRNN + ch + 4) * xb; }
        }
        *(u32x4*)(U + (size_t)orow * DRNN + ch) = pack8(y[0], y[1]);
    }
}
__device__ __forceinline__ void scan_apply(const bf16_t* HL, const bf16_t* AC, const bf16_t* GATE, bf16_t* Y, const float* CARRY) {
    const Ctx c = mkctx();
    const int ncg = DRNN / 8, total = MR * ncg;
    for (int it = c.gtid; it < total; it += 4 * c.gthreads) {
        u32x4 vh[4], va[4], vg[4];
#pragma unroll
        for (int k = 0; k < 4; ++k) { const int i = it + k * c.gthreads; if (i < total) { const size_t o = (size_t)(i / ncg) * DRNN + (i % ncg) * 8; vh[k] = __builtin_nontemporal_load((const u32x4*)(HL + o)); va[k] = __builtin_nontemporal_load((const u32x4*)(AC + o)); vg[k] = __builtin_nontemporal_load((const u32x4*)(GATE + o)); } }
#pragma unroll
        for (int k = 0; k < 4; ++k) { const int i = it + k * c.gthreads; if (i < total) {
            const int row = i / ncg, ch = (i % ncg) * 8; const size_t o = (size_t)row * DRNN + ch;
            f32x4 c0 = (f32x4){0.f, 0.f, 0.f, 0.f}, c1 = c0;
            if (row < RT) { const float* cp = CARRY + (size_t)(row >> 7) * DRNN + ch; c0 = *(const f32x4*)cp; c1 = *(const f32x4*)(cp + 4); }
            f32x4 h0, h1, a0, a1, g0, g1; unpack8(vh[k], h0, h1); unpack8(va[k], a0, a1); unpack8(vg[k], g0, g1);
            *(u32x4*)(Y + o) = pack8((h0 + a0 * c0) * g0, (h1 + a1 * c1) * g1); } }
    }
}
__device__ __forceinline__ void scan_carry(const float* AGGA, const float* AGGH, float* CARRY) {
    const Ctx c = mkctx();
    const int idx = c.gtid;
    if (idx >= NBATCH * DRNN * 16) return;
    const int seg = idx & 15, ch = (idx >> 4) % DRNN, b = (idx >> 4) / DRNN;
    const int G0 = 128 * b + 8 * seg;
    float a[8], h[8];
#pragma unroll
    for (int i = 0; i < 8; ++i) { a[i] = AGGA[(size_t)(G0 + i) * DRNN + ch]; h[i] = AGGH[(size_t)(G0 + i) * DRNN + ch]; }
    float A = 1.f, H = 0.f;
#pragma unroll
    for (int i = 0; i < 8; ++i) { H = a[i] * H + h[i]; A = a[i] * A; }
#pragma unroll
    for (int d = 1; d < 16; d <<= 1) {
        const float Ap = __shfl_up(A, d, 16), Hp = __shfl_up(H, d, 16);
        if (seg >= d) { H = A * Hp + H; A = A * Ap; }
    }
    float Ae = __shfl_up(A, 1, 16), He = __shfl_up(H, 1, 16);
    if (seg == 0) { Ae = 1.f; He = 0.f; }
    float cy = He + Ae * AGGH[(size_t)256 * DRNN + ch];
#pragma unroll
    for (int i = 0; i < 8; ++i) { CARRY[(size_t)(G0 + i) * DRNN + ch] = cy; cy = a[i] * cy + h[i]; }
}

__device__ __forceinline__ void final_norm(float* out, const bf16_t* HB, const float* SS, const float* gfin) {
    const Ctx c = mkctx();
    const int total = RT * (D / 8);
    for (int it = c.gtid; it < total; it += 4 * c.gthreads) {
        u32x4 v[4]; float rs[4];
#pragma unroll
        for (int k = 0; k < 4; ++k) { const int i = it + k * c.gthreads; const int row = i >> 7, col = (i & 127) * 8;
            if (i < total) { v[k] = *(const u32x4*)(HB + (size_t)row * D + col); rs[k] = SS[row]; } }
#pragma unroll
        for (int k = 0; k < 4; ++k) { const int i = it + k * c.gthreads; const int row = i >> 7, col = (i & 127) * 8;
            if (i < total) { f32x4 a, b; unpack8(v[k], a, b); const float r_ = rs_from_ss(rs[k]);
                *(f32x4*)(out + (size_t)row * D + col) = a * r_ * *(const f32x4*)(gfin + col); *(f32x4*)(out + (size_t)row * D + col + 4) = b * r_ * *(const f32x4*)(gfin + col + 4); } }
    }
}

#define XB_TMO      128
#define XB_XCNT(j)  (256  + 64 * (j))
#define XB_XSUB(j)  (1280 + 64 * (j))
#define XB_XGEN(j)  (2304 + 64 * (j))
#define XB_TOP      3328
#define XB_TOPGEN   3392
#define XCD_BAR_WORDS 3456
#define XB_SPIN_CAP (1u << 18)
__device__ __forceinline__ unsigned xb_ld(unsigned* p)              { return __hip_atomic_load(p, __ATOMIC_RELAXED, __HIP_MEMORY_SCOPE_AGENT); }
__device__ __forceinline__ unsigned xb_add(unsigned* p, unsigned v) { return __hip_atomic_fetch_add(p, v, __ATOMIC_RELAXED, __HIP_MEMORY_SCOPE_AGENT); }
__device__ __forceinline__ unsigned xb_xcc_id() { return (unsigned)__builtin_amdgcn_s_getreg((3 << 11) | 20) & 0xFu; }
#define XB_SPIN(cond, bar) do { unsigned _sp = 0; while (cond) { __builtin_amdgcn_s_sleep(1); \
    if ((++_sp & 255u) == 0u) { if (xb_ld(&(bar)[XB_TMO])) break; if (_sp > XB_SPIN_CAP) { atomicAdd(&(bar)[XB_TMO], 1u); break; } } } } while (0)
struct XcdBarrier { unsigned* bar; unsigned x; volatile LAS unsigned* st; };
__device__ __forceinline__ XcdBarrier xcd_barrier_post(unsigned* bar, volatile LAS unsigned* st) {
    XcdBarrier b; b.bar = bar; b.x = xb_xcc_id(); b.st = st;
    if (threadIdx.x == 0) (void)xb_add(&bar[XB_XCNT(b.x)], 1u);
    return b;
}
__device__ __forceinline__ void xcd_barrier_complete(unsigned* bar, unsigned x, unsigned& nloc, unsigned& nx) {
    const unsigned G = gridDim.x * gridDim.y * gridDim.z;
    unsigned sum, cnt, mine, sp = 0u;
    for (;;) {
        sum = 0u; cnt = 0u; mine = 0u;
#pragma unroll
        for (unsigned j = 0; j < 16; ++j) { const unsigned c = xb_ld(&bar[XB_XCNT(j)]); sum += c; cnt += (c > 0u) ? 1u : 0u; mine = (j == x) ? c : mine; }
        if (sum == G) break;
        __builtin_amdgcn_s_sleep(1);
        if ((++sp & 255u) == 0u) { if (xb_ld(&bar[XB_TMO])) break; if (sp > XB_SPIN_CAP) { atomicAdd(&bar[XB_TMO], 1u); break; } }
    }
    nloc = mine > 0u ? mine : 1u; nx = cnt > 0u ? cnt : 1u;
}
__device__ __forceinline__ void xcd_barrier(const XcdBarrier& b) {
    asm volatile("s_waitcnt vmcnt(0)" ::: "memory");
    __syncthreads();
    if (threadIdx.x == 0) {
        unsigned* bar = b.bar;
        __builtin_amdgcn_s_waitcnt(0);
        unsigned nloc = b.st[0], nx = b.st[1];
        if (nloc == 0u) { xcd_barrier_complete(bar, b.x, nloc, nx); b.st[0] = nloc; b.st[1] = nx; }
        const unsigned old = xb_add(&bar[XB_XSUB(b.x)], 1u);
        const unsigned gen = old / nloc;
        if (old + 1u == (gen + 1u) * nloc) {
            __builtin_amdgcn_fence(__ATOMIC_RELEASE, "agent");
            asm volatile("s_waitcnt vmcnt(0)" ::: "memory");
            const unsigned og = xb_add(&bar[XB_TOP], 1u);
            const unsigned tg = og / nx;
            if (og + 1u == (tg + 1u) * nx) xb_add(&bar[XB_TOPGEN], 1u);
            else XB_SPIN(xb_ld(&bar[XB_TOPGEN]) == tg, bar);
            __builtin_amdgcn_fence(__ATOMIC_ACQUIRE, "agent");
            xb_add(&bar[XB_XGEN(b.x)], 1u);
            asm volatile("s_waitcnt vmcnt(0)" ::: "memory");
        } else {
            XB_SPIN(xb_ld(&bar[XB_XGEN(b.x)]) == gen, bar);
            __builtin_amdgcn_fence(__ATOMIC_ACQUIRE, "agent");
            asm volatile("s_waitcnt vmcnt(0)" ::: "memory");
        }
    }
    __syncthreads();
}

constexpr int LDS_BYTES = 147456;
#define GSYNC() xcd_barrier(xbar)

__global__ void __launch_bounds__(NTHREADS) fwd_megakernel(Params p) {
    extern __shared__ __attribute__((aligned(16))) unsigned char lds_raw[];
    LAS unsigned char* lds = (LAS unsigned char*)lds_raw;
    cg::grid_group grid = cg::this_grid();
    const int NG = gridDim.x;
    if (threadIdx.x < 2) ((volatile LAS unsigned*)(lds + 131072 + 512))[threadIdx.x] = 0u;
    __syncthreads();
    const XcdBarrier xbar = xcd_barrier_post((unsigned*)(p.ws + WS_BAR), (volatile LAS unsigned*)(lds + 131072 + 512));
    unsigned char* ws = p.ws;
    float* SS = (float*)(ws + WS_SS);
    float* SP = (float*)(ws + WS_SP);
    float* AGGA = (float*)(ws + WS_AGGA); float* AGGH = (float*)(ws + WS_AGGH); float* CARRY = (float*)(ws + WS_CARRY);
    float* PRE = (float*)(ws + WS_PRE);
    bf16_t* W = (bf16_t*)(ws + WS_W);
    bf16_t* HB = (bf16_t*)(ws + WS_HB);
    bf16_t* S0 = (bf16_t*)(ws + WS_SCR); bf16_t* S1 = (bf16_t*)(ws + WS_SCR + SCR_STRIDE); bf16_t* S2 = (bf16_t*)(ws + WS_SCR + 2 * SCR_STRIDE); bf16_t* S3 = (bf16_t*)(ws + WS_SCR + 3 * SCR_STRIDE);
    pg8::StaticOrder S;

    grid.sync();
    prep_phase(p, lds);
    GSYNC();
    { bf16_t* CV = S0; bf16_t* Bg = S1; bf16_t* Z = S2;
      { pg8::Gemm g{HB, W + OW1, D, 1024, 0}; S.init(128, 12, NG, blockIdx.x); EpiScIn E{SS, CV, Bg};
        pg8::gemm_phase(lds, g, S, E); pg8::mini_gemm(lds, g, 12, E); }
      GSYNC();
      conv_pass<3, true, false>(CV, Bg, Z, p.in[I_SCCONV], nullptr, D);
      GSYNC();
      { pg8::Gemm g{Z, W + OW2, D, 1024, 0}; S.init(128, 4, NG, blockIdx.x); EpiResid E{HB, SS + SS_STRIDE};
        pg8::gemm_phase(lds, g, S, E); pg8::mini_gemm(lds, g, 4, E); }
      GSYNC(); }
    { bf16_t* ACT = S0;
      { pg8::Gemm g{HB, W + OW3, D, 1024, 0}; S.init(128, 22, NG, blockIdx.x); EpiFfnUp E{SS + SS_STRIDE, (const float*)(ws + WS_FCW), ACT, PRE};
        pg8::gemm_phase(lds, g, S, E); pg8::mini_gemm(lds, g, 22, E); }
      GSYNC();
      ffn_fixup(PRE, p.in[I_FFCONV], ACT);
      GSYNC();
      { pg8::Gemm g{ACT, W + OW4, DFF, 2816, 0}; S.init(128, 4, NG, blockIdx.x); EpiResid E{HB, SS + 2 * SS_STRIDE};
        pg8::gemm_phase(lds, g, S, E); pg8::mini_gemm(lds, g, 4, E); }
      GSYNC(); }
    { bf16_t* GATE = S0; bf16_t* HL = S1; bf16_t* U = S2; bf16_t* Y = S2; bf16_t* AC = S3;
      { pg8::Gemm g{HB, W + OW5, D, 1024, 0}; S.init(128, 10, NG, blockIdx.x); EpiRgIn E{SS + 2 * SS_STRIDE, p.in[I_RGCONV], p.in[I_RGCONVB], GATE, U, PRE};
        pg8::gemm_phase(lds, g, S, E); pg8::mini_gemm(lds, g, 10, E); }
      GSYNC();
      rg_fixup(PRE, p.in[I_RGCONV], p.in[I_RGCONVB], U);
      GSYNC();
      { pg8::Gemm g{U, W + OW6, DRNN, 128, 128}; S.init(128, 10, NG, blockIdx.x); EpiRgGate E{U, p.in[I_RGBA], p.in[I_RGBX], SP, HL, AC, AGGA, AGGH};
        pg8::gemm_phase(lds, g, S, E); pg8::mini_gemm(lds, g, 10, E); }
      GSYNC();
      scan_carry(AGGA, AGGH, CARRY);
      GSYNC();
      scan_apply(HL, AC, GATE, Y, CARRY);
      GSYNC();
      { pg8::Gemm g{Y, W + OW7, DRNN, 1280, 0}; S.init(128, 4, NG, blockIdx.x); EpiResid E{HB, SS + 3 * SS_STRIDE};
        pg8::gemm_phase(lds, g, S, E); pg8::mini_gemm(lds, g, 4, E); }
      GSYNC(); }
    { bf16_t* ACT = S0;
      { pg8::Gemm g{HB, W + OW8, D, 1024, 0}; S.init(128, 22, NG, blockIdx.x); EpiFfnUp E{SS + 3 * SS_STRIDE, (const float*)(ws + WS_FCW) + 3 * 2 * DFF, ACT, PRE};
        pg8::gemm_phase(lds, g, S, E); pg8::mini_gemm(lds, g, 22, E); }
      GSYNC();
      ffn_fixup(PRE, p.in[I_FFCONV] + 3 * 2 * DFF, ACT);
      GSYNC();
      { pg8::Gemm g{ACT, W + OW9, DFF, 2816, 0}; S.init(128, 4, NG, blockIdx.x); EpiResidFinal E{HB, SS + 4 * SS_STRIDE, (unsigned*)(ws + WS_CNT), p.in[I_FNG], p.out};
        pg8::gemm_phase(lds, g, S, E); } }
}

extern "C" void kernel_launch(void* const* d_in, const int* in_sizes, int n_in, void* d_out, int out_size, void* d_ws, size_t ws_size, hipStream_t stream) {
    static int grid = 0;
    if (grid == 0) {
        if (n_in != 20 || ws_size < WS_NEED) { fprintf(stderr, "kernel_launch: unexpected n_in %d / ws_size %zu\n", n_in, ws_size); grid = -1; return; }
        int dev = 0, cus = 0, per_cu = 0;
        hipGetDevice(&dev);
        hipDeviceGetAttribute(&cus, hipDeviceAttributeMultiprocessorCount, dev);
        if (hipFuncSetAttribute((const void*)fwd_megakernel, hipFuncAttributeMaxDynamicSharedMemorySize, LDS_BYTES) != hipSuccess) { fprintf(stderr, "kernel_launch: hipFuncSetAttribute failed\n"); grid = -1; return; }
        if (hipOccupancyMaxActiveBlocksPerMultiprocessor(&per_cu, (const void*)fwd_megakernel, NTHREADS, LDS_BYTES) != hipSuccess || per_cu < 1) { fprintf(stderr, "kernel_launch: occupancy query says %d\n", per_cu); grid = -1; return; }
        grid = cus;
    }
    if (grid < 0) return;
    Params p{};
    for (int i = 0; i < 20; ++i) p.in[i] = (const float*)d_in[i];
    p.out = (float*)d_out; p.ws = (unsigned char*)d_ws;
    if (hipMemsetAsync((char*)d_ws + WS_BAR, 0, (WS_CNT - WS_BAR) + 128 * 64 * 4, stream) != hipSuccess) { fprintf(stderr, "kernel_launch: memset failed\n"); return; }
    void* args[] = {&p};
    hipError_t e = hipLaunchCooperativeKernel((const void*)fwd_megakernel, dim3(grid), dim3(NTHREADS), args, LDS_BYTES, stream);
    if (e != hipSuccess) fprintf(stderr, "cooperative launch failed: %s (grid %d)\n", hipGetErrorString(e), grid);
}
```

```cpp
#include <hip/hip_runtime.h>
#include <hip/hip_cooperative_groups.h>
#include <cstdio>
#include <cstdint>
namespace cg = cooperative_groups;

#define LAS __attribute__((address_space(3)))
typedef unsigned short bf16_t;
typedef short bf16x8 __attribute__((ext_vector_type(8)));
typedef float f32x4 __attribute__((ext_vector_type(4)));
typedef unsigned u32x4 __attribute__((ext_vector_type(4)));
typedef unsigned u32x2 __attribute__((ext_vector_type(2)));
typedef float f32x2 __attribute__((ext_vector_type(2)));

constexpr int D = 1024, SEQ = 16384, NBATCH = 2, NMETA = 16;
constexpr int RT = NBATCH * SEQ;
constexpr int MROW0 = RT;
constexpr int MR = RT + NMETA;
constexpr int MPAD = 32800;
constexpr int DRNN = 1280, DFF = 2816;
constexpr float EPS = 1e-6f;
constexpr int NTHREADS = 512;

constexpr size_t MiB = 1u << 20;
constexpr size_t SS_STRIDE = 65536;
constexpr size_t WS_SS = 0;
constexpr size_t WS_SP = 1536 * 1024;
constexpr size_t WS_HMETA = 1600 * 1024;
constexpr size_t WS_FCW = 1800 * 1024;
constexpr size_t WS_CNT = 1716 * 1024;
constexpr size_t WS_BAR = 1700 * 1024;
constexpr size_t WS_AGGA = 2 * MiB, WS_AGGH = 4 * MiB, WS_CARRY = 6 * MiB;
constexpr size_t WS_PRE = 8 * MiB;
constexpr size_t WS_W = 32 * MiB;
constexpr size_t WS_HB = 84 * MiB;
constexpr size_t WS_SCR = 150 * MiB;
constexpr size_t WS_NEED = 480 * MiB;
constexpr size_t OW1 = 0, OW2 = OW1 + 3072ull * 1024, OW3 = OW2 + 1024ull * 1024, OW4 = OW3 + 5632ull * 1024, OW5 = OW4 + 1024ull * 2816,
                 OW6 = OW5 + 2560ull * 1024, OW7 = OW6 + 2560ull * 128, OW8 = OW7 + 1024ull * 1280, OW9 = OW8 + 5632ull * 1024, OWEND = OW9 + 1024ull * 2816;
static_assert(OWEND * 2 <= 52 * MiB, "weights");
constexpr size_t SCR_STRIDE = 81 * MiB;
constexpr int PRE_ROWS = 1040;

struct Params {
    const float* in[20];
    float* out;
    unsigned char* ws;
};
enum { I_X = 0, I_META, I_NMG, I_NFG, I_FNG, I_SCWIN, I_SCCONV, I_SCWOUT, I_RGWIN, I_RGCONV, I_RGCONVB, I_RGWA, I_RGBA, I_RGWX, I_RGBX, I_RGLAM, I_RGWOUT, I_FFUP, I_FFCONV, I_FFDOWN };

__device__ __forceinline__ unsigned cvt_pk_bf16(float lo, float hi) { unsigned r; asm("v_cvt_pk_bf16_f32 %0, %1, %2" : "=v"(r) : "v"(lo), "v"(hi)); return r; }
__device__ __forceinline__ float bf_lo(unsigned u) { return __uint_as_float(u << 16); }
__device__ __forceinline__ float bf_hi(unsigned u) { return __uint_as_float(u & 0xffff0000u); }
__device__ __forceinline__ u32x4 pack8(const f32x4 a, const f32x4 b) { u32x4 w; w.x = cvt_pk_bf16(a[0], a[1]); w.y = cvt_pk_bf16(a[2], a[3]); w.z = cvt_pk_bf16(b[0], b[1]); w.w = cvt_pk_bf16(b[2], b[3]); return w; }
__device__ __forceinline__ void unpack8(const u32x4 w, f32x4& a, f32x4& b) { a = (f32x4){bf_lo(w.x), bf_hi(w.x), bf_lo(w.y), bf_hi(w.y)}; b = (f32x4){bf_lo(w.z), bf_hi(w.z), bf_lo(w.w), bf_hi(w.w)}; }
__device__ __forceinline__ float fast_exp(float x) { return __builtin_amdgcn_exp2f(x * 1.44269504f); }
__device__ __forceinline__ float fast_rcp(float x) { return __builtin_amdgcn_rcpf(x); }
__device__ __forceinline__ float sigmoidf_(float x) { return fast_rcp(1.0f + fast_exp(-x)); }
__device__ __forceinline__ float siluf_(float x) { return x * sigmoidf_(x); }
__device__ __forceinline__ float gelu_tanh_(float x) { const float u = x * (-2.3022082f + -0.1029432f * (x * x)); return x * fast_rcp(1.0f + __builtin_amdgcn_exp2f(u)); }
__device__ __forceinline__ float dpp_shr1(float v) { return __int_as_float(__builtin_amdgcn_update_dpp(0, __float_as_int(v), 0x111, 0xF, 0xF, true)); }
template <int N> __device__ __forceinline__ float dpp_shr(float v, float oldv) { return __int_as_float(__builtin_amdgcn_update_dpp(__float_as_int(oldv), __float_as_int(v), 0x110 + N, 0xF, 0xF, false)); }
__device__ __forceinline__ float rs_from_ss(float ss) { return __builtin_amdgcn_rsqf(ss * (1.0f / 1024.0f) + EPS); }

namespace pg8 {
constexpr int BM = 256, BK = 64, HALF = 128, HTB = HALF * BK * 2, STAGE_BYTES = 8 * HTB, NXCD = 8, WGM = 4;
__host__ __device__ __forceinline__ int lds_byte(int r, int c) { const int st = (r >> 4) * 2 + (c >> 5), rr = r & 15, cc = c & 31, ob = rr * 64 + cc * 2; return st * 1024 + (ob ^ (((ob >> 9) & 1) << 5)); }
__host__ __device__ __forceinline__ void stage_rc(int b, int& R, int& C) { const int st = b / 1024, sb = b % 1024, swz = sb ^ (((sb >> 9) & 1) << 5); R = (st >> 1) * 16 + swz / 64; C = (st & 1) * 32 + (swz % 64) / 2; }
__host__ __device__ __forceinline__ int perm32(int rho) { const int n = rho >> 4, i = rho & 15; return 8 * (i >> 2) + 4 * n + (i & 3); }

struct Unit { int pm, pn; };
constexpr int CB_OFF = 131072 + 1024, CB_SIZE = 4096;
struct Gemm { const bf16_t* A; const bf16_t* Bt; int lda, K, a_pn_off; int ldb = 0; };

struct StaticOrder {
    int nM, nN, nwg, G, c;
    __device__ void init(int nM_, int nN_, int G_, int c_) { nM = nM_; nN = nN_; nwg = nM * nN; G = G_; c = c_; }
    __device__ bool next(int i, Unit& u) const {
        const long L = (long)i * G + c; if (L >= nwg) return false;
        int wgid = (int)L; { const int q = nwg / NXCD, r = nwg % NXCD, xcd = wgid % NXCD, off = wgid / NXCD; wgid = (xcd < r ? xcd * (q + 1) : r * (q + 1) + (xcd - r) * q) + off; }
        const int nig = WGM * nN, gid = wgid / nig, fm = gid * WGM, gsz = (nM - fm) < WGM ? (nM - fm) : WGM;
        u.pm = fm + ((wgid % nig) % gsz); u.pn = (wgid % nig) / gsz; return true;
    }
};

template <class Epi>
__device__ __forceinline__ void gemm_phase(LAS unsigned char* lds, const Gemm g, const StaticOrder& S, const Epi& E) {
    int tid = threadIdx.x; asm volatile("" : "+v"(tid));
    const int wid = __builtin_amdgcn_readfirstlane(tid >> 6), lane = tid & 63, wr = wid >> 2, wc = wid & 3, fr = lane & 15, fq = lane >> 4;
    const int K = g.K, nt = K / BK, lda = g.lda, ldb = g.ldb ? g.ldb : g.K;
    unsigned voffA[2], voffB[2];
#pragma unroll
    for (int i = 0; i < 2; ++i) { int R, C; stage_rc(tid * 16 + i * 8192, R, C); const int Rb = (R & ~31) + perm32(R & 31);
        const int Ra = Epi::TOKPERM ? (128 * (R >> 6) + 8 * (R & 15) + ((R >> 4) & 3)) : R;
        voffA[i] = (unsigned)(Ra * lda + C) * 2u; voffB[i] = (unsigned)(Rb * ldb + C) * 2u; }
    const size_t kstep = (size_t)(BK * 2);
    const size_t hA = Epi::TOKPERM ? (size_t)4 * lda * 2 : (size_t)HALF * lda * 2;
    const size_t hB = (size_t)HALF * ldb * 2;
    const size_t tA = (size_t)BM * lda * 2, tB = 2 * hB;
    const size_t apo = (size_t)g.a_pn_off * 2;
    const unsigned ldsw = (unsigned)wid * 1024u;
    const int aoff = lds_byte(wr * 64 + fr, fq * 8), boff = lds_byte(wc * 32 + fr, fq * 8);
#define PG8_SA(b, h) (((b) * 2 + (h)) * HTB)
#define PG8_SB(b, h) ((4 + (b) * 2 + (h)) * HTB)
#define PG8_STAGE(bufoff, gbase, voff) do { _Pragma("unroll") for (int _i = 0; _i < 2; ++_i) \
        __builtin_amdgcn_global_load_lds((const unsigned*)((const char*)(gbase) + (voff)[_i]), (LAS unsigned*)(lds + (bufoff) + ldsw + _i * 8192), 16, 0, 0); } while (0)
#define PG8_LDA(dst, b, h) do { _Pragma("unroll") for (int m = 0; m < 4; ++m) _Pragma("unroll") for (int k = 0; k < 2; ++k) dst[m][k] = *(const LAS bf16x8*)(lds + PG8_SA(b, h) + aoff + m * 2048 + k * 1024); } while (0)
#define PG8_LDB(dst, b, h) do { _Pragma("unroll") for (int n = 0; n < 2; ++n) _Pragma("unroll") for (int k = 0; k < 2; ++k) dst[n][k] = *(const LAS bf16x8*)(lds + PG8_SB(b, h) + boff + n * 2048 + k * 1024); } while (0)
#define PG8_MMA(ai, bj, At, Bt) do { __builtin_amdgcn_s_setprio(1); _Pragma("unroll") for (int m = 0; m < 4; ++m) _Pragma("unroll") for (int n = 0; n < 2; ++n) _Pragma("unroll") for (int k = 0; k < 2; ++k) \
        acc[ai][bj][m][n] = __builtin_amdgcn_mfma_f32_16x16x32_bf16(Bt[n][k], At[m][k], acc[ai][bj][m][n], 0, 0, 0); __builtin_amdgcn_s_setprio(0); } while (0)
#define PG8_WAIT_V(n) asm volatile("s_waitcnt vmcnt(" #n ")" ::: "memory")
#define PG8_WAIT_L(n) asm volatile("s_waitcnt lgkmcnt(" #n ")" ::: "memory")
#define PG8_BAR __builtin_amdgcn_s_barrier()
#define PG8_SCHED __builtin_amdgcn_sched_barrier(0)
    Unit cur, nxt; int ui = 0;
    if (!S.next(0, cur)) return;
    f32x4 acc[2][2][4][2];
#pragma unroll
    for (int a = 0; a < 2; ++a)
#pragma unroll
        for (int b = 0; b < 2; ++b)
#pragma unroll
            for (int m = 0; m < 4; ++m)
#pragma unroll
                for (int n = 0; n < 2; ++n) acc[a][b][m][n] = (f32x4){0.f, 0.f, 0.f, 0.f};
    bf16x8 At[4][2], B0[2][2], B1[2][2];
    const char* cA = (const char*)g.A + (size_t)cur.pm * tA + (size_t)cur.pn * apo; const char* cB = (const char*)g.Bt + (size_t)cur.pn * tB;
    E.prefetch(lds + CB_OFF, cur, wid, lane);
    PG8_STAGE(PG8_SB(0, 0), cB, voffB); PG8_STAGE(PG8_SB(0, 1), cB + hB, voffB); PG8_STAGE(PG8_SA(0, 0), cA, voffA); PG8_STAGE(PG8_SA(0, 1), cA + hA, voffA);
    if (wr == 1) PG8_BAR;
    PG8_WAIT_V(2); PG8_BAR;
    PG8_STAGE(PG8_SB(1, 0), cB + kstep, voffB); PG8_STAGE(PG8_SA(1, 0), cA + kstep, voffA); PG8_STAGE(PG8_SB(1, 1), cB + hB + kstep, voffB);
    PG8_WAIT_V(6); PG8_BAR;
    for (;;) {
        const bool has_next = S.next(ui + 1, nxt);
        const char* nA = has_next ? (const char*)g.A + (size_t)nxt.pm * tA + (size_t)nxt.pn * apo : cA; const char* nB = has_next ? (const char*)g.Bt + (size_t)nxt.pn * tB : cB;
        for (int t = 0; t < nt; t += 2) {
            const bool last = (t == nt - 2);
            const char* a1 = cA + (size_t)(t + 1) * kstep;
            const char* a2 = last ? nA : cA + (size_t)(t + 2) * kstep; const char* b2 = last ? nB : cB + (size_t)(t + 2) * kstep;
            const char* a3 = a2 + kstep; const char* b3 = b2 + kstep;
            PG8_LDB(B0, 0, 0); PG8_LDB(B1, 0, 1); PG8_SCHED; PG8_LDA(At, 0, 0); PG8_STAGE(PG8_SA(1, 1), a1 + hA, voffA);
            PG8_WAIT_V(8); PG8_WAIT_L(0); PG8_BAR; PG8_MMA(0, 0, At, B0); PG8_MMA(0, 1, At, B1); PG8_BAR; PG8_SCHED;
            PG8_LDA(At, 0, 1); PG8_STAGE(PG8_SB(0, 0), b2, voffB); PG8_STAGE(PG8_SB(0, 1), b2 + hB, voffB); PG8_STAGE(PG8_SA(0, 0), a2, voffA);
            PG8_WAIT_V(8); PG8_WAIT_L(0); PG8_BAR; PG8_MMA(1, 0, At, B0); PG8_MMA(1, 1, At, B1); PG8_BAR; PG8_SCHED;
            PG8_LDB(B0, 1, 0); PG8_LDB(B1, 1, 1); PG8_SCHED; PG8_LDA(At, 1, 0); PG8_STAGE(PG8_SA(0, 1), a2 + hA, voffA);
            PG8_WAIT_V(8); PG8_WAIT_L(0); PG8_BAR; PG8_MMA(0, 0, At, B0); PG8_MMA(0, 1, At, B1); PG8_BAR; PG8_SCHED;
            PG8_LDA(At, 1, 1); PG8_STAGE(PG8_SB(1, 0), b3, voffB); PG8_STAGE(PG8_SB(1, 1), b3 + hB, voffB); PG8_STAGE(PG8_SA(1, 0), a3, voffA);
            PG8_WAIT_V(8); PG8_WAIT_L(0); PG8_BAR; PG8_MMA(1, 0, At, B0); PG8_MMA(1, 1, At, B1); PG8_BAR; PG8_SCHED;
        }
        if constexpr (Epi::ALIGN) { if (wr == 0) PG8_BAR; }
        E.main(acc, cur, wr, wc, fr, fq, lds + CB_OFF + (ui & 1) * CB_SIZE);
        if (!has_next) break;
#pragma unroll
        for (int a = 0; a < 2; ++a)
#pragma unroll
            for (int b = 0; b < 2; ++b)
#pragma unroll
                for (int m = 0; m < 4; ++m)
#pragma unroll
                    for (int n = 0; n < 2; ++n) acc[a][b][m][n] = (f32x4){0.f, 0.f, 0.f, 0.f};
        cur = nxt; cA = nA; cB = nB; ++ui;
        E.prefetch(lds + CB_OFF + (ui & 1) * CB_SIZE, cur, wid, lane);
        if constexpr (Epi::ALIGN) { if (wr == 1) PG8_BAR; }
    }
    PG8_WAIT_V(0);
    if constexpr (!Epi::ALIGN) { if (wr == 0) PG8_BAR; }
    PG8_BAR;
#undef PG8_SA
#undef PG8_SB
#undef PG8_STAGE
#undef PG8_LDA
#undef PG8_LDB
#undef PG8_MMA
#undef PG8_WAIT_V
#undef PG8_WAIT_L
#undef PG8_BAR
#undef PG8_SCHED
}

template <class Epi>
__device__ __forceinline__ void mini_gemm(LAS unsigned char* lds, const Gemm g, int nN, const Epi& E) {
    int tid = threadIdx.x; asm volatile("" : "+v"(tid));
    const int wid = __builtin_amdgcn_readfirstlane(tid >> 6), lane = tid & 63, fr = lane & 15, fq = lane >> 4;
    const int task = (int)blockIdx.x;
    if (task >= nN * 4) return;
    const int pn = task >> 2, wc = task & 3, K = g.K;
    const int kw = (K / 32 + 7) / 8 * 32;
    const int k0 = wid * kw, k1 = (k0 + kw < K) ? k0 + kw : K;
    const bf16_t* ap = g.A + (size_t)(MROW0 + fr) * g.lda + (size_t)pn * g.a_pn_off + 8 * fq;
    const bf16_t* bp[2][2];
#pragma unroll
    for (int bj = 0; bj < 2; ++bj)
#pragma unroll
        for (int n = 0; n < 2; ++n) bp[bj][n] = g.Bt + (size_t)(256 * pn + 128 * bj + 32 * wc + 8 * (fr >> 2) + 4 * n + (fr & 3)) * K + 8 * fq;
    f32x4 acc[2][2];
#pragma unroll
    for (int bj = 0; bj < 2; ++bj)
#pragma unroll
        for (int n = 0; n < 2; ++n) acc[bj][n] = (f32x4){0.f, 0.f, 0.f, 0.f};
#pragma unroll 4
    for (int kk = k0; kk < k1; kk += 32) {
        const bf16x8 a = *(const bf16x8*)(ap + kk);
#pragma unroll
        for (int bj = 0; bj < 2; ++bj)
#pragma unroll
            for (int n = 0; n < 2; ++n) { const bf16x8 b = *(const bf16x8*)(bp[bj][n] + kk); acc[bj][n] = __builtin_amdgcn_mfma_f32_16x16x32_bf16(b, a, acc[bj][n], 0, 0, 0); }
    }
    LAS f32x4* red = (LAS f32x4*)lds;
#pragma unroll
    for (int i = 0; i < 4; ++i) red[(wid * 4 + i) * 64 + lane] = acc[i >> 1][i & 1];
    __syncthreads();
    if (wid == 0) {
#pragma unroll
        for (int w = 1; w < 8; ++w)
#pragma unroll
            for (int i = 0; i < 4; ++i) acc[i >> 1][i & 1] += red[(w * 4 + i) * 64 + lane];
        E.mini(fr, pn, wc * 32 + 8 * fq, fq, acc[0][0], acc[0][1], acc[1][0], acc[1][1]);
    }
    __syncthreads();
}
}

__device__ __forceinline__ void dma16(const float* gsrc_lane, LAS unsigned char* dst) { __builtin_amdgcn_global_load_lds((const unsigned*)gsrc_lane, (LAS unsigned*)dst, 16, 0, 0); }

template <class Epi>
__device__ __forceinline__ void epi_items(const Epi& E, f32x4 (&acc)[2][2][4][2], const pg8::Unit& u, int wr, int wc, int fr, int fq) {
#pragma unroll
    for (int ai = 0; ai < 2; ++ai)
#pragma unroll
        for (int m = 0; m < 4; ++m) {
            const int row = u.pm * 256 + ai * 128 + wr * 64 + m * 16 + fr;
            E.item(row, u.pn, wc * 32 + 8 * fq, fq, acc[ai][0][m][0], acc[ai][0][m][1], acc[ai][1][m][0], acc[ai][1][m][1]);
            asm volatile("" ::: "memory");
        }
}

struct EpiScIn {
    static constexpr bool TOKPERM = false;
    static constexpr bool ALIGN = true;
    __device__ __forceinline__ void prefetch(LAS unsigned char* cb, const pg8::Unit& u, int wid, int lane) const { if (wid == 0) dma16(SS + u.pm * 256 + lane * 4, cb); }
    const float* SS; bf16_t* CV; bf16_t* B;
    __device__ __forceinline__ void item(int row, float rs, int pn, int cw, f32x4 a0, f32x4 a1, f32x4 b0, f32x4 b1) const {
        if (pn < 8) {
            const float r2 = rs * rs;
            *(u32x4*)(CV + (size_t)row * D + pn * 128 + cw) = pack8(a0 * b0 * r2, a1 * b1 * r2);
        } else {
            bf16_t* p = B + (size_t)row * D + (pn - 8) * 256 + cw;
            *(u32x4*)p = pack8(a0 * rs, a1 * rs); *(u32x4*)(p + 128) = pack8(b0 * rs, b1 * rs);
        }
    }
    __device__ __forceinline__ void main(f32x4 (&acc)[2][2][4][2], const pg8::Unit& u, int wr, int wc, int fr, int fq, LAS unsigned char* cb) const {
        const int rbase = u.pm * 256 + wr * 64 + fr;
        const LAS float* ssl = (const LAS float*)cb + wr * 64 + fr;
        float ss[8];
#pragma unroll
        for (int i = 0; i < 8; ++i) ss[i] = ssl[(i >> 2) * 128 + (i & 3) * 16];
#pragma unroll
        for (int i = 0; i < 8; ++i) item(rbase + (i >> 2) * 128 + (i & 3) * 16, rs_from_ss(ss[i]), u.pn, wc * 32 + 8 * fq, acc[i >> 2][0][i & 3][0], acc[i >> 2][0][i & 3][1], acc[i >> 2][1][i & 3][0], acc[i >> 2][1][i & 3][1]);
    }
    __device__ __forceinline__ void mini(int mrow, int pn, int cw, int fq, f32x4 a0, f32x4 a1, f32x4 b0, f32x4 b1) const { item(MROW0 + mrow, rs_from_ss(SS[MROW0 + mrow]), pn, cw, a0, a1, b0, b1); }
};

struct EpiResid {
    static constexpr bool TOKPERM = false;
    static constexpr bool ALIGN = false;
    __device__ __forceinline__ void prefetch(LAS unsigned char*, const pg8::Unit&, int, int) const {}
    bf16_t* HB; float* SSo;
    __device__ __forceinline__ float finish(bf16_t* hb, const u32x4 r0, const u32x4 r1, f32x4 a0, f32x4 a1, f32x4 b0, f32x4 b1) const {
        f32x4 x0, x1, y0, y1; unpack8(r0, x0, x1); unpack8(r1, y0, y1);
        a0 += x0; a1 += x1; b0 += y0; b1 += y1;
        *(u32x4*)hb = pack8(a0, a1); *(u32x4*)(hb + 128) = pack8(b0, b1);
        const f32x4 q = a0 * a0 + a1 * a1 + b0 * b0 + b1 * b1;
        float sq = (q[0] + q[1]) + (q[2] + q[3]);
        sq += __shfl_xor(sq, 16); sq += __shfl_xor(sq, 32);
        return sq;
    }
    __device__ __forceinline__ void main(f32x4 (&acc)[2][2][4][2], const pg8::Unit& u, int wr, int wc, int fr, int fq, LAS unsigned char* cb) const {
        const int col = u.pn * 256 + wc * 32 + 8 * fq, rbase = u.pm * 256 + wr * 64 + fr;
        bf16_t* hb0 = HB + (size_t)rbase * D + col;
        u32x4 r[8][2];
#pragma unroll
        for (int i = 0; i < 8; ++i) { const bf16_t* q_ = hb0 + (size_t)((i >> 2) * 128 + (i & 3) * 16) * D; r[i][0] = *(const u32x4*)q_; r[i][1] = *(const u32x4*)(q_ + 128); }
#pragma unroll
        for (int ai = 0; ai < 2; ++ai) {
            float sq[4];
#pragma unroll
            for (int m = 0; m < 4; ++m) {
                const int i = ai * 4 + m, ro = ai * 128 + m * 16;
                sq[m] = finish(hb0 + (size_t)ro * D, r[i][0], r[i][1], acc[ai][0][m][0], acc[ai][0][m][1], acc[ai][1][m][0], acc[ai][1][m][1]);
            }
            const float ssel = (fq == 0) ? sq[0] : (fq == 1) ? sq[1] : (fq == 2) ? sq[2] : sq[3];
            atomicAdd(SSo + rbase + ai * 128 + fq * 16, ssel);
        }
    }
    __device__ __forceinline__ void mini(int mrow, int pn, int cw, int fq, f32x4 a0, f32x4 a1, f32x4 b0, f32x4 b1) const {
        bf16_t* hb = HB + (size_t)(MROW0 + mrow) * D + pn * 256 + cw;
        const float sq = finish(hb, *(const u32x4*)hb, *(const u32x4*)(hb + 128), a0, a1, b0, b1);
        if (fq == 0) atomicAdd(SSo + MROW0 + mrow, sq);
    }
};

struct EpiResidFinal {
    static constexpr bool TOKPERM = false;
    static constexpr bool ALIGN = true;
    __device__ __forceinline__ void prefetch(LAS unsigned char*, const pg8::Unit&, int, int) const {}
    const bf16_t* HB; float* SS; unsigned* cnt; const float* gfin; float* out;
    __device__ __forceinline__ void main(f32x4 (&acc)[2][2][4][2], const pg8::Unit& u, int wr, int wc, int fr, int fq, LAS unsigned char* cb) const {
        const int col = u.pn * 256 + wc * 32 + 8 * fq, rbase = u.pm * 256 + wr * 64 + fr;
        const bf16_t* hb0 = HB + (size_t)rbase * D + col;
        u32x4 r[8][2];
#pragma unroll
        for (int i = 0; i < 8; ++i) { const bf16_t* q_ = hb0 + (size_t)((i >> 2) * 128 + (i & 3) * 16) * D; r[i][0] = *(const u32x4*)q_; r[i][1] = *(const u32x4*)(q_ + 128); }
#pragma unroll
        for (int ai = 0; ai < 2; ++ai) {
            float sq[4];
#pragma unroll
            for (int m = 0; m < 4; ++m) {
                f32x4 x0, x1, y0, y1; unpack8(r[ai * 4 + m][0], x0, x1); unpack8(r[ai * 4 + m][1], y0, y1);
                acc[ai][0][m][0] += x0; acc[ai][0][m][1] += x1; acc[ai][1][m][0] += y0; acc[ai][1][m][1] += y1;
                const f32x4 q = acc[ai][0][m][0] * acc[ai][0][m][0] + acc[ai][0][m][1] * acc[ai][0][m][1] + acc[ai][1][m][0] * acc[ai][1][m][0] + acc[ai][1][m][1] * acc[ai][1][m][1];
                float t = (q[0] + q[1]) + (q[2] + q[3]);
                t += __shfl_xor(t, 16); t += __shfl_xor(t, 32);
                sq[m] = t;
            }
            const float ssel = (fq == 0) ? sq[0] : (fq == 1) ? sq[1] : (fq == 2) ? sq[2] : sq[3];
            atomicAdd(SS + rbase + ai * 128 + fq * 16, ssel);
        }
        asm volatile("s_waitcnt vmcnt(0)" ::: "memory");
        unsigned* pc = cnt + 64 * u.pm;
        if ((threadIdx.x & 63) == 0) (void)__hip_atomic_fetch_add(pc, 1u, __ATOMIC_RELAXED, __HIP_MEMORY_SCOPE_AGENT);
        { unsigned sp = 0;
          while ((unsigned)__builtin_amdgcn_readfirstlane(__hip_atomic_load(pc, __ATOMIC_RELAXED, __HIP_MEMORY_SCOPE_AGENT)) < 32u) { __builtin_amdgcn_s_sleep(1); if (++sp > (1u << 20)) break; } }
        const f32x4 g00 = *(const f32x4*)(gfin + col), g01 = *(const f32x4*)(gfin + col + 4), g10 = *(const f32x4*)(gfin + col + 128), g11 = *(const f32x4*)(gfin + col + 132);
#pragma unroll
        for (int ai = 0; ai < 2; ++ai)
#pragma unroll
            for (int m = 0; m < 4; ++m) {
                const int row = rbase + ai * 128 + m * 16;
                const float rs = rs_from_ss(__hip_atomic_load(SS + row, __ATOMIC_RELAXED, __HIP_MEMORY_SCOPE_AGENT));
                float* o = out + (size_t)row * D + col;
                *(f32x4*)o = acc[ai][0][m][0] * rs * g00; *(f32x4*)(o + 4) = acc[ai][0][m][1] * rs * g01;
                *(f32x4*)(o + 128) = acc[ai][1][m][0] * rs * g10; *(f32x4*)(o + 132) = acc[ai][1][m][1] * rs * g11;
            }
    }
};

struct EpiFfnUp {
    static constexpr bool TOKPERM = true;
    static constexpr bool ALIGN = true;
    __device__ __forceinline__ void prefetch(LAS unsigned char* cb, const pg8::Unit& u, int wid, int lane) const {
        if (wid == 0) dma16(SS + u.pm * 256 + lane * 4, cb);
        else if (wid < 4) { const int k6 = 2 * (wid - 1) + (lane >> 5); dma16(cw_ + k6 * DFF + u.pn * 128 + (lane & 31) * 4, cb + 1024 + (wid - 1) * 1024); }
    }
    const float* SS; const float* cw_;
    bf16_t* ACT; float* PRE;
    __device__ __forceinline__ void main(f32x4 (&acc)[2][2][4][2], const pg8::Unit& u, int wr, int wc, int fr, int fq, LAS unsigned char* cb) const {
        const int tok0 = u.pm * 256 + wr * 128 + fr * 8;
        const int chb = u.pn * 128 + wc * 32 + fq * 8;
        const f32x4 s0 = *(const LAS f32x4*)(cb + (wr * 128 + fr * 8) * 4), s1 = *(const LAS f32x4*)(cb + (wr * 128 + fr * 8 + 4) * 4);
        f32x4 cwv[2][6];
#pragma unroll
        for (int n = 0; n < 2; ++n)
#pragma unroll
            for (int k6 = 0; k6 < 6; ++k6) cwv[n][k6] = *(const LAS f32x4*)(cb + 1024 + k6 * 512 + (wc * 32 + fq * 8 + 4 * n) * 4);
#pragma unroll
        for (int m = 0; m < 4; ++m) {
            const float r0 = rs_from_ss(s0[m]), r1 = rs_from_ss(s1[m]);
#pragma unroll
            for (int bj = 0; bj < 2; ++bj)
#pragma unroll
                for (int n = 0; n < 2; ++n) { acc[0][bj][m][n] *= r0; acc[1][bj][m][n] *= r1; }
        }
        const int grp = u.pm * 2 + wr;
        if (fr == 0 || fr == 15) {
            const bool lo = (fr == 0);
            bf16_t* P16 = (bf16_t*)PRE;
#pragma unroll
            for (int j = 0; j < 2; ++j) {
                const f32x4 g0 = lo ? acc[0][0][j][0] : acc[1][0][2 + j][0], g1 = lo ? acc[0][0][j][1] : acc[1][0][2 + j][1];
                const f32x4 v0 = lo ? acc[0][1][j][0] : acc[1][1][2 + j][0], v1 = lo ? acc[0][1][j][1] : acc[1][1][2 + j][1];
                bf16_t* p = P16 + (size_t)(4 * grp + (lo ? 0 : 2) + j) * (2 * DFF) + chb;
                *(u32x4*)p = pack8(g0, g1); *(u32x4*)(p + DFF) = pack8(v0, v1);
            }
        }
        f32x4 hg[2][2], hv[2][2];
#pragma unroll
        for (int n = 0; n < 2; ++n)
#pragma unroll
            for (int e = 0; e < 4; ++e) {
                hg[0][n][e] = dpp_shr1(acc[1][0][2][n][e]); hg[1][n][e] = dpp_shr1(acc[1][0][3][n][e]);
                hv[0][n][e] = dpp_shr1(acc[1][1][2][n][e]); hv[1][n][e] = dpp_shr1(acc[1][1][3][n][e]);
            }
#pragma unroll
        for (int j = 0; j < 8; ++j) {
            f32x4 res[2];
#pragma unroll
            for (int n = 0; n < 2; ++n) {
                const f32x4 g0 = acc[j >> 2][0][j & 3][n], v0 = acc[j >> 2][1][j & 3][n];
                const f32x4 g1 = (j >= 1) ? acc[(j - 1) >> 2][0][(j - 1) & 3][n] : hg[1][n], v1 = (j >= 1) ? acc[(j - 1) >> 2][1][(j - 1) & 3][n] : hv[1][n];
                const f32x4 g2 = (j >= 2) ? acc[(j - 2) >> 2][0][(j - 2) & 3][n] : hg[j][n], v2 = (j >= 2) ? acc[(j - 2) >> 2][1][(j - 2) & 3][n] : hv[j][n];
                const f32x4 yg = cwv[n][0] * g2 + cwv[n][2] * g1 + cwv[n][4] * g0;
                const f32x4 yv = cwv[n][1] * v2 + cwv[n][3] * v1 + cwv[n][5] * v0;
                f32x4 ex;
#pragma unroll
                for (int e = 0; e < 4; ++e) ex[e] = __builtin_amdgcn_exp2f(yg[e]);
                const f32x4 dn = ex + 1.0f;
                f32x4 rc;
#pragma unroll
                for (int e = 0; e < 4; ++e) rc[e] = fast_rcp(dn[e]);
                res[n] = (yg * rc) * yv;
            }
            if (!(fr == 0 && j < 2)) __builtin_nontemporal_store(pack8(res[0], res[1]), (u32x4*)(ACT + (size_t)(tok0 + j) * DFF + chb));
        }
    }
    __device__ __forceinline__ void mini(int mrow, int pn, int cw, int fq, f32x4 a0, f32x4 a1, f32x4 b0, f32x4 b1) const {
        const float rs = rs_from_ss(SS[MROW0 + mrow]);
        bf16_t* p = (bf16_t*)PRE + (size_t)(1024 + mrow) * (2 * DFF) + pn * 128 + cw;
        *(u32x4*)p = pack8(a0 * rs, a1 * rs); *(u32x4*)(p + DFF) = pack8(b0 * rs, b1 * rs);
    }
};

struct EpiRgIn {
    static constexpr bool TOKPERM = true;
    static constexpr bool ALIGN = true;
    __device__ __forceinline__ void prefetch(LAS unsigned char* cb, const pg8::Unit& u, int wid, int lane) const {
        if (wid == 0) dma16(SS + u.pm * 256 + lane * 4, cb);
        else if (wid < 4) { int k = 2 * (wid - 1) + (lane >> 5); k = k > 4 ? 4 : k; const float* src = (k < 4) ? cw_ + k * DRNN : cb_; dma16(src + u.pn * 128 + (lane & 31) * 4, cb + 1024 + (wid - 1) * 1024); }
    }
    const float* SS; const float* cw_; const float* cb_;
    bf16_t* GATE; bf16_t* U; float* PRE;
    __device__ __forceinline__ void main(f32x4 (&acc)[2][2][4][2], const pg8::Unit& u, int wr, int wc, int fr, int fq, LAS unsigned char* cb) const {
        const int tok0 = u.pm * 256 + wr * 128 + fr * 8;
        const int chb = u.pn * 128 + wc * 32 + fq * 8;
        const f32x4 s0 = *(const LAS f32x4*)(cb + (wr * 128 + fr * 8) * 4), s1 = *(const LAS f32x4*)(cb + (wr * 128 + fr * 8 + 4) * 4);
        f32x4 cwv[2][5];
#pragma unroll
        for (int n = 0; n < 2; ++n)
#pragma unroll
            for (int k = 0; k < 5; ++k) cwv[n][k] = *(const LAS f32x4*)(cb + 1024 + k * 512 + (wc * 32 + fq * 8 + 4 * n) * 4);
#pragma unroll
        for (int m = 0; m < 4; ++m) {
            const float r0 = rs_from_ss(s0[m]), r1 = rs_from_ss(s1[m]);
#pragma unroll
            for (int bj = 0; bj < 2; ++bj)
#pragma unroll
                for (int n = 0; n < 2; ++n) { acc[0][bj][m][n] *= r0; acc[1][bj][m][n] *= r1; }
        }
#pragma unroll
        for (int j = 0; j < 8; ++j) {
            f32x4 a0 = acc[j >> 2][0][j & 3][0], a1 = acc[j >> 2][0][j & 3][1];
#pragma unroll
            for (int e = 0; e < 4; ++e) { a0[e] = gelu_tanh_(a0[e]); a1[e] = gelu_tanh_(a1[e]); }
            __builtin_nontemporal_store(pack8(a0, a1), (u32x4*)(GATE + (size_t)(tok0 + j) * DRNN + chb));
        }
        const int grp = u.pm * 2 + wr;
        if (fr == 0 || fr == 15) {
            const bool lo = (fr == 0);
            bf16_t* P16 = (bf16_t*)PRE;
#pragma unroll
            for (int j = 0; j < 3; ++j) {
                const f32x4 x0 = lo ? acc[0][1][j][0] : acc[1][1][1 + j][0], x1 = lo ? acc[0][1][j][1] : acc[1][1][1 + j][1];
                *(u32x4*)(P16 + (size_t)(6 * grp + (lo ? 0 : 3) + j) * DRNN + chb) = pack8(x0, x1);
            }
        }
#pragma unroll
        for (int n = 0; n < 2; ++n)
#pragma unroll
            for (int e = 0; e < 4; ++e) {
                const float pm1 = dpp_shr1(acc[1][1][3][n][e]), pm2 = dpp_shr1(acc[1][1][2][n][e]), pm3 = dpp_shr1(acc[1][1][1][n][e]);
                const float w0 = cwv[n][0][e], w1 = cwv[n][1][e], w2 = cwv[n][2][e], w3 = cwv[n][3][e], bs = cwv[n][4][e];
#pragma unroll
                for (int j = 7; j >= 0; --j) {
                    const float x0 = acc[j >> 2][1][j & 3][n][e];
                    const float x1 = (j >= 1) ? acc[(j - 1) >> 2][1][(j - 1) & 3][n][e] : pm1;
                    const float x2 = (j >= 2) ? acc[(j - 2) >> 2][1][(j - 2) & 3][n][e] : (j == 1 ? pm1 : pm2);
                    const float x3 = (j >= 3) ? acc[(j - 3) >> 2][1][(j - 3) & 3][n][e] : (j == 2 ? pm1 : (j == 1 ? pm2 : pm3));
                    acc[j >> 2][1][j & 3][n][e] = bs + w0 * x3 + w1 * x2 + w2 * x1 + w3 * x0;
                }
            }
#pragma unroll
        for (int j = 0; j < 8; ++j)
            if (!(fr == 0 && j < 3)) *(u32x4*)(U + (size_t)(tok0 + j) * DRNN + chb) = pack8(acc[j >> 2][1][j & 3][0], acc[j >> 2][1][j & 3][1]);
    }
    __device__ __forceinline__ void mini(int mrow, int pn, int cw, int fq, f32x4 a0, f32x4 a1, f32x4 b0, f32x4 b1) const {
        const float rs = rs_from_ss(SS[MROW0 + mrow]);
        a0 *= rs; a1 *= rs;
#pragma unroll
        for (int e = 0; e < 4; ++e) { a0[e] = gelu_tanh_(a0[e]); a1[e] = gelu_tanh_(a1[e]); }
        *(u32x4*)(GATE + (size_t)(MROW0 + mrow) * DRNN + pn * 128 + cw) = pack8(a0, a1);
        *(u32x4*)((bf16_t*)PRE + (size_t)(1536 + mrow) * DRNN + pn * 128 + cw) = pack8(b0 * rs, b1 * rs);
    }
};

struct EpiRgGate {
    static constexpr bool TOKPERM = true;
    static constexpr bool ALIGN = true;
    __device__ __forceinline__ void prefetch(LAS unsigned char*, const pg8::Unit&, int, int) const {}
    const bf16_t* U; const float* ba; const float* bx; const float* SP; bf16_t* HL; bf16_t* AC; float* AGGA; float* AGGH;
    __device__ __forceinline__ void ab(float pa, float px, float vba, float vbx, float vsp, float u, float& a, float& b) const {
        const float r = sigmoidf_(pa + vba), ig = sigmoidf_(px + vbx); const float la = -r * vsp;
        a = fast_exp(la); const float om = (1.0f - a) * (1.0f + a); b = __builtin_amdgcn_sqrtf(om) * ig * u;
    }
    __device__ __forceinline__ void main(f32x4 (&acc)[2][2][4][2], const pg8::Unit& u, int wr, int wc, int fr, int fq, LAS unsigned char* cb) const {
        const int tok0 = u.pm * 256 + wr * 128 + fr * 8;
        const int ch = u.pn * 128 + wc * 32 + fq * 8;
        const int grp = u.pm * 2 + wr;
        u32x4 ur[8];
#pragma unroll
        for (int j = 0; j < 8; ++j) ur[j] = *(const u32x4*)(U + (size_t)(tok0 + j) * DRNN + ch);
        f32x4 kc[2][3];
#pragma unroll
        for (int n = 0; n < 2; ++n) { kc[n][0] = *(const f32x4*)(ba + ch + 4 * n); kc[n][1] = *(const f32x4*)(bx + ch + 4 * n); kc[n][2] = *(const f32x4*)(SP + ch + 4 * n); }
#pragma unroll
        for (int n = 0; n < 2; ++n) {
            const f32x4 vba = kc[n][0], vbx = kc[n][1], vsp = kc[n][2];
            f32x4 aggA, aggH;
#pragma unroll
            for (int e = 0; e < 4; ++e) {
                float cA = 1.f, cH = 0.f;
#pragma unroll
                for (int j = 0; j < 8; ++j) {
                    const unsigned uw = (n == 0) ? ((e < 2) ? ur[j].x : ur[j].y) : ((e < 2) ? ur[j].z : ur[j].w);
                    const float uu = (e & 1) ? bf_hi(uw) : bf_lo(uw);
                    float a, b; ab(acc[j >> 2][0][j & 3][n][e], acc[j >> 2][1][j & 3][n][e], vba[e], vbx[e], vsp[e], uu, a, b);
                    cH = a * cH + b; cA = a * cA;
                    acc[j >> 2][0][j & 3][n][e] = cH; acc[j >> 2][1][j & 3][n][e] = cA;
                }
                float A = cA, H = cH;
                { const float Ap = dpp_shr<1>(A, 1.f), Hp = dpp_shr<1>(H, 0.f); H = A * Hp + H; A = A * Ap; }
                { const float Ap = dpp_shr<2>(A, 1.f), Hp = dpp_shr<2>(H, 0.f); H = A * Hp + H; A = A * Ap; }
                { const float Ap = dpp_shr<4>(A, 1.f), Hp = dpp_shr<4>(H, 0.f); H = A * Hp + H; A = A * Ap; }
                { const float Ap = dpp_shr<8>(A, 1.f), Hp = dpp_shr<8>(H, 0.f); H = A * Hp + H; A = A * Ap; }
                aggA[e] = A; aggH[e] = H;
                const float Aex = dpp_shr<1>(A, 1.f), Hex = dpp_shr<1>(H, 0.f);
#pragma unroll
                for (int j = 0; j < 8; ++j) {
                    const float hl = acc[j >> 2][0][j & 3][n][e], ac = acc[j >> 2][1][j & 3][n][e];
                    acc[j >> 2][0][j & 3][n][e] = hl + ac * Hex; acc[j >> 2][1][j & 3][n][e] = ac * Aex;
                }
            }
            if (fr == 15) { *(f32x4*)(AGGA + (size_t)grp * DRNN + ch + 4 * n) = aggA; *(f32x4*)(AGGH + (size_t)grp * DRNN + ch + 4 * n) = aggH; }
        }
#pragma unroll
        for (int j = 0; j < 8; ++j) {
            const size_t o = (size_t)(tok0 + j) * DRNN + ch;
            __builtin_nontemporal_store(pack8(acc[j >> 2][0][j & 3][0], acc[j >> 2][0][j & 3][1]), (u32x4*)(HL + o));
            __builtin_nontemporal_store(pack8(acc[j >> 2][1][j & 3][0], acc[j >> 2][1][j & 3][1]), (u32x4*)(AC + o));
        }
    }
    __device__ __forceinline__ void mini(int mrow, int pn, int cw, int fq, f32x4 a0, f32x4 a1, f32x4 b0, f32x4 b1) const {
        const int ch = pn * 128 + cw; const size_t o = (size_t)(MROW0 + mrow) * DRNN + ch;
        f32x4 u0, u1; unpack8(*(const u32x4*)(U + o), u0, u1);
        f32x4 hl[2], ac[2];
#pragma unroll
        for (int n = 0; n < 2; ++n) {
            const f32x4 vba = *(const f32x4*)(ba + ch + 4 * n), vbx = *(const f32x4*)(bx + ch + 4 * n), vsp = *(const f32x4*)(SP + ch + 4 * n);
#pragma unroll
            for (int e = 0; e < 4; ++e) {
                float A, H; ab(n ? a1[e] : a0[e], n ? b1[e] : b0[e], vba[e], vbx[e], vsp[e], n ? u1[e] : u0[e], A, H);
                { const float Ap = dpp_shr<1>(A, 1.f), Hp = dpp_shr<1>(H, 0.f); H = A * Hp + H; A = A * Ap; }
                { const float Ap = dpp_shr<2>(A, 1.f), Hp = dpp_shr<2>(H, 0.f); H = A * Hp + H; A = A * Ap; }
                { const float Ap = dpp_shr<4>(A, 1.f), Hp = dpp_shr<4>(H, 0.f); H = A * Hp + H; A = A * Ap; }
                { const float Ap = dpp_shr<8>(A, 1.f), Hp = dpp_shr<8>(H, 0.f); H = A * Hp + H; A = A * Ap; }
                hl[n][e] = H; ac[n][e] = A;
            }
            if (mrow == 15) { *(f32x4*)(AGGA + (size_t)256 * DRNN + ch + 4 * n) = ac[n]; *(f32x4*)(AGGH + (size_t)256 * DRNN + ch + 4 * n) = hl[n]; }
        }
        *(u32x4*)(HL + o) = pack8(hl[0], hl[1]);
        *(u32x4*)(AC + o) = pack8(ac[0], ac[1]);
    }
};

struct Ctx { int tid, gtid, gthreads, G, wid, lane; };
__device__ __forceinline__ Ctx mkctx() { Ctx c; int t = threadIdx.x; asm volatile("" : "+v"(t)); c.tid = t; c.G = gridDim.x; c.gtid = blockIdx.x * NTHREADS + t; c.gthreads = c.G * NTHREADS;
    c.wid = __builtin_amdgcn_readfirstlane(t >> 6); c.lane = t & 63; return c; }

__device__ __forceinline__ void wjob(const Params& p, int job, int q, const float*& src, const float*& gain, bf16_t*& dst, int& K, int& Nsrc, int& col0) {
    bf16_t* W = (bf16_t*)(p.ws + WS_W);
    gain = nullptr;
    switch (job) {
    case 0: src = p.in[I_SCWIN]; gain = p.in[I_NMG]; dst = W + OW1; K = 1024; Nsrc = 3072; col0 = (q < 16) ? (((q & 1) ? 2048 : 1024) + 128 * (q >> 1)) : 128 * (q - 16); break;
    case 1: src = p.in[I_SCWOUT]; dst = W + OW2; K = 1024; Nsrc = 1024; col0 = 128 * q; break;
    case 2: src = p.in[I_FFUP]; gain = p.in[I_NFG]; dst = W + OW3; K = 1024; Nsrc = 5632; col0 = ((q & 1) ? DFF : 0) + 128 * (q >> 1); break;
    case 3: src = p.in[I_FFDOWN]; dst = W + OW4; K = 2816; Nsrc = 1024; col0 = 128 * q; break;
    case 4: src = p.in[I_RGWIN]; gain = p.in[I_NMG] + 1024; dst = W + OW5; K = 1024; Nsrc = 2560; col0 = ((q & 1) ? DRNN : 0) + 128 * (q >> 1); break;
    case 5: src = p.in[I_RGWOUT]; dst = W + OW7; K = 1280; Nsrc = 1024; col0 = 128 * q; break;
    case 6: src = p.in[I_FFUP] + (size_t)1024 * 5632; gain = p.in[I_NFG] + 1024; dst = W + OW8; K = 1024; Nsrc = 5632; col0 = ((q & 1) ? DFF : 0) + 128 * (q >> 1); break;
    case 7: src = p.in[I_FFDOWN] + (size_t)2816 * 1024; dst = W + OW9; K = 2816; Nsrc = 1024; col0 = 128 * q; break;
    default: src = ((q & 1) ? p.in[I_RGWX] : p.in[I_RGWA]) + (size_t)(q >> 1) * 16384; dst = W + OW6; K = 128; Nsrc = 128; col0 = 0; break;
    }
}
__device__ __forceinline__ void prep_phase(const Params& p, LAS unsigned char* lds) {
    const Ctx c = mkctx();
    float* SS = (float*)(p.ws + WS_SS);
    for (int i = c.gtid; i < 4 * (int)SS_STRIDE; i += c.gthreads) SS[SS_STRIDE + i] = 0.f;
    { float* FCW = (float*)(p.ws + WS_FCW); const float* fw = p.in[I_FFCONV];
      for (int i = c.gtid; i < 2 * 3 * 2 * DFF; i += c.gthreads) FCW[i] = fw[i] * (((i % (2 * DFF)) < DFF) ? -1.44269504f : -0.69314718f); }
    { float* SP = (float*)(p.ws + WS_SP); const float* lam = p.in[I_RGLAM];
      for (int i = c.gtid; i < DRNN; i += c.gthreads) SP[i] = 8.0f * log1pf(expf(-lam[i])); }
    { bf16_t* HB = (bf16_t*)(p.ws + WS_HB);
      for (int r0 = (blockIdx.x * 8 + c.wid) * 4; r0 < MR; r0 += c.G * 32) {
          f32x4 a[4][2], b[4][2];
#pragma unroll
          for (int k = 0; k < 4; ++k) { const int row = r0 + k;
              const float* src = (row < RT) ? p.in[I_X] + (size_t)row * D : p.in[I_META] + (size_t)(row - RT) * D;
#pragma unroll
              for (int i = 0; i < 2; ++i) { const int col = i * 512 + c.lane * 8; a[k][i] = __builtin_nontemporal_load((const f32x4*)(src + col)); b[k][i] = __builtin_nontemporal_load((const f32x4*)(src + col + 4)); } }
#pragma unroll
          for (int k = 0; k < 4; ++k) { const int row = r0 + k; float s = 0.f;
#pragma unroll
              for (int i = 0; i < 2; ++i) { const int col = i * 512 + c.lane * 8; const f32x4 q = a[k][i] * a[k][i] + b[k][i] * b[k][i]; s += (q[0] + q[1]) + (q[2] + q[3]);
                  *(u32x4*)(HB + (size_t)row * D + col) = pack8(a[k][i], b[k][i]); }
#pragma unroll
              for (int o = 32; o >= 1; o >>= 1) s += __shfl_xor(s, o);
              if (c.lane == 0) SS[row] = s; }
      } }
    LAS bf16_t* T = (LAS bf16_t*)lds;
    const int j4 = (c.tid & 31) * 4, kp = c.tid >> 5;
    f32x4 va[2][2];
    bf16_t* dstc = nullptr; int Kc = 0, qc = 0, kbc = 0;
#define WITEM_DECODE(it_, job_, q_, kb_) do { int base_ = 0; job_ = 0; \
        if (it_ >= 384) { ++job_; base_ = 384; } if (it_ >= 512) { ++job_; base_ = 512; } if (it_ >= 1216) { ++job_; base_ = 1216; } if (it_ >= 1568) { ++job_; base_ = 1568; } \
        if (it_ >= 1888) { ++job_; base_ = 1888; } if (it_ >= 2048) { ++job_; base_ = 2048; } if (it_ >= 2752) { ++job_; base_ = 2752; } if (it_ >= 3104) { ++job_; base_ = 3104; } \
        const int li_ = it_ - base_; const int Kj_ = (job_ == 3 || job_ == 7) ? 2816 : (job_ == 5 ? 1280 : (job_ == 8 ? 128 : 1024)); const int nkb_ = Kj_ / 64; q_ = li_ / nkb_; kb_ = li_ % nkb_; } while (0)
#define WITEM_LOAD(it_, vv, dst_, K_, q_, kb_) do { int job_; WITEM_DECODE(it_, job_, q_, kb_); const float* src_; const float* gain_; int Nsrc_, col0_; \
        wjob(p, job_, q_, src_, gain_, dst_, K_, Nsrc_, col0_); \
        _Pragma("unroll") for (int ps = 0; ps < 2; ++ps) { const int k_ = kb_ * 64 + 2 * (kp + 16 * ps); \
            vv[ps][0] = __builtin_nontemporal_load((const f32x4*)(src_ + (size_t)k_ * Nsrc_ + col0_ + j4)); vv[ps][1] = __builtin_nontemporal_load((const f32x4*)(src_ + (size_t)(k_ + 1) * Nsrc_ + col0_ + j4)); \
            if (gain_) { vv[ps][0] *= gain_[k_]; vv[ps][1] *= gain_[k_ + 1]; } } } while (0)
    int it = blockIdx.x;
    if (it < 3144) WITEM_LOAD(it, va, dstc, Kc, qc, kbc);
    for (; it < 3144; it += c.G) {
        f32x4 vb[2][2]; bf16_t* dstn = nullptr; int Kn = 0, qn = 0, kbn = 0;
        const int nx = it + c.G;
        if (nx < 3144) WITEM_LOAD(nx, vb, dstn, Kn, qn, kbn);
        {
            LAS unsigned* T32 = (LAS unsigned*)T;
#pragma unroll
            for (int ps = 0; ps < 2; ++ps) { const int x = kp + 16 * ps;
#pragma unroll
                for (int e = 0; e < 4; ++e) { const int j = j4 + e; T32[j * 36 + (x ^ (((j >> 2) & 7) << 2))] = cvt_pk_bf16(va[ps][0][e], va[ps][1][e]); } }
        }
        __syncthreads();
        {
            const int jr = c.tid >> 3, seg = c.tid & 7;
            const LAS unsigned* T32 = (const LAS unsigned*)T;
#pragma unroll
            for (int ps = 0; ps < 2; ++ps) {
                const int j = jr + 64 * ps;
                const u32x4 w = *(const LAS u32x4*)(T32 + j * 36 + ((4 * seg) ^ (((j >> 2) & 7) << 2)));
                *(u32x4*)(dstc + (size_t)(128 * qc + j) * Kc + kbc * 64 + seg * 8) = w;
            }
        }
        __syncthreads();
#pragma unroll
        for (int ps = 0; ps < 2; ++ps) { va[ps][0] = vb[ps][0]; va[ps][1] = vb[ps][1]; }
        dstc = dstn; Kc = Kn; qc = qn; kbc = kbn;
    }
#undef WITEM_LOAD
#undef WITEM_DECODE
}

template <int KW, bool GATE, bool BIAS>
__device__ __forceinline__ void conv_pass(const bf16_t* X, const bf16_t* Bg, bf16_t* Y, const float* w, const float* bias, int C) {
    const Ctx c = mkctx();
    const int ncg = C / 8, nchunks = MR / 16, total = ncg * nchunks;
    for (int it = c.gtid; it < total; it += c.gthreads) {
        const int ck = it / ncg, cgp = it % ncg, ch = cgp * 8, row0 = ck * 16;
        f32x4 wa[KW], wb[KW];
#pragma unroll
        for (int k = 0; k < KW; ++k) { wa[k] = *(const f32x4*)(w + (size_t)k * C + ch); wb[k] = *(const f32x4*)(w + (size_t)k * C + ch + 4); }
        f32x4 bsa = (f32x4){0.f, 0.f, 0.f, 0.f}, bsb = bsa;
        if (BIAS) { bsa = *(const f32x4*)(bias + ch); bsb = *(const f32x4*)(bias + ch + 4); }
        f32x4 ha[KW - 1], hb[KW - 1];
        const bool ismeta = (ck == nchunks - 1);
        const bool bstart = (!ismeta) && ((row0 & (SEQ - 1)) == 0);
#pragma unroll
        for (int k = 0; k < KW - 1; ++k) {
            if (ismeta) { ha[k] = (f32x4){0.f, 0.f, 0.f, 0.f}; hb[k] = ha[k]; }
            else { const int pr = bstart ? (MROW0 + NMETA - (KW - 1) + k) : (row0 - (KW - 1) + k);
                   unpack8(*(const u32x4*)(X + (size_t)pr * C + ch), ha[k], hb[k]); }
        }
#pragma unroll
        for (int r = 0; r < 16; ++r) {
            f32x4 xa, xb; unpack8(__builtin_nontemporal_load((const u32x4*)(X + (size_t)(row0 + r) * C + ch)), xa, xb);
            f32x4 ya = wa[KW - 1] * xa + bsa, yb = wb[KW - 1] * xb + bsb;
#pragma unroll
            for (int k = 0; k < KW - 1; ++k) { ya += wa[k] * ha[k]; yb += wb[k] * hb[k]; }
#pragma unroll
            for (int k = 0; k < KW - 2; ++k) { ha[k] = ha[k + 1]; hb[k] = hb[k + 1]; }
            ha[KW - 2] = xa; hb[KW - 2] = xb;
            if (GATE) { f32x4 ga, gb; unpack8(__builtin_nontemporal_load((const u32x4*)(Bg + (size_t)(row0 + r) * C + ch)), ga, gb); ya *= ga; yb *= gb; }
            *(u32x4*)(Y + (size_t)(row0 + r) * C + ch) = pack8(ya, yb);
        }
    }
}

__device__ __forceinline__ void ffn_fixup(const float* PRE, const float* cw_, bf16_t* ACT) {
    const Ctx c = mkctx();
    const int ncg = DFF / 8, total = 528 * ncg;
    for (int it = c.gtid; it < total; it += c.gthreads) {
        const int rid = it / ncg, ch = (it % ncg) * 8;
        int r0, r1, r2, orow;
        if (rid < 512) {
            const int G = rid >> 1, j = rid & 1;
            const int pl0 = ((G & 127) == 0) ? 1024 + 14 : 4 * (G - 1) + 2, pl1 = pl0 + 1;
            if (j == 0) { r0 = pl0; r1 = pl1; r2 = 4 * G; } else { r0 = pl1; r1 = 4 * G; r2 = 4 * G + 1; }
            orow = 128 * G + j;
        } else {
            const int m = rid - 512; r2 = 1024 + m; r1 = (m >= 1) ? 1024 + m - 1 : -1; r0 = (m >= 2) ? 1024 + m - 2 : -1; orow = MROW0 + m;
        }
        f32x4 y[2][2];
        const bf16_t* P16 = (const bf16_t*)PRE;
#pragma unroll
        for (int hv = 0; hv < 2; ++hv) {
            const int col = hv * DFF + ch;
            const f32x4 z = (f32x4){0.f, 0.f, 0.f, 0.f};
            f32x4 x0a = z, x0b = z, x1a = z, x1b = z, x2a, x2b;
            if (r0 >= 0) unpack8(*(const u32x4*)(P16 + (size_t)r0 * (2 * DFF) + col), x0a, x0b);
            if (r1 >= 0) unpack8(*(const u32x4*)(P16 + (size_t)r1 * (2 * DFF) + col), x1a, x1b);
            unpack8(*(const u32x4*)(P16 + (size_t)r2 * (2 * DFF) + col), x2a, x2b);
            y[hv][0] = *(const f32x4*)(cw_ + col) * x0a + *(const f32x4*)(cw_ + 2 * DFF + col) * x1a + *(const f32x4*)(cw_ + 4 * DFF + col) * x2a;
            y[hv][1] = *(const f32x4*)(cw_ + col + 4) * x0b + *(const f32x4*)(cw_ + 2 * DFF + col + 4) * x1b + *(const f32x4*)(cw_ + 4 * DFF + col + 4) * x2b;
        }
#pragma unroll
        for (int n = 0; n < 2; ++n)
#pragma unroll
            for (int e = 0; e < 4; ++e) y[0][n][e] = siluf_(y[0][n][e]) * y[1][n][e];
        *(u32x4*)(ACT + (size_t)orow * DFF + ch) = pack8(y[0][0], y[0][1]);
    }
}

__device__ __forceinline__ void rg_fixup(const float* PRE, const float* cw_, const float* cb_, bf16_t* U) {
    const Ctx c = mkctx();
    const int ncg = DRNN / 8, total = 784 * ncg;
    for (int it = c.gtid; it < total; it += c.gthreads) {
        const int rid = it / ncg, ch = (it % ncg) * 8;
        int rr[4], orow;
        if (rid < 768) {
            const int G = rid / 3, j = rid % 3;
            const int pl = ((G & 127) == 0) ? 1536 + 13 : 6 * (G - 1) + 3;
#pragma unroll
            for (int k = 0; k < 4; ++k) { const int q = j + k; rr[k] = (q < 3) ? pl + q : 6 * G + (q - 3); }
            orow = 128 * G + j;
        } else {
            const int m = rid - 768;
#pragma unroll
            for (int k = 0; k < 4; ++k) { const int q = m - 3 + k; rr[k] = (q >= 0) ? 1536 + q : -1; }
            orow = MROW0 + m;
        }
        f32x4 y[2];
        y[0] = *(const f32x4*)(cb_ + ch); y[1] = *(const f32x4*)(cb_ + ch + 4);
        const bf16_t* P16 = (const bf16_t*)PRE;
#pragma unroll
        for (int k = 0; k < 4; ++k) {
            if (rr[k] >= 0) { f32x4 xa, xb; unpack8(*(const u32x4*)(P16 + (size_t)rr[k] * DRNN + ch), xa, xb);
                y[0] += *(const f32x4*)(cw_ + k * DRNN + ch) * xa; y[1] += *(const f32x4*)(cw_ + k * DRNN + ch + 4) * xb; }
        }
        *(u32x4*)(U + (size_t)orow * DRNN + ch) = pack8(y[0], y[1]);
    }
}
__device__ __forceinline__ void scan_apply(const bf16_t* HL, const bf16_t* AC, const bf16_t* GATE, bf16_t* Y, const float* CARRY) {
    const Ctx c = mkctx();
    const int ncg = DRNN / 8, total = MR * ncg;
    for (int it = c.gtid; it < total; it += 4 * c.gthreads) {
        u32x4 vh[4], va[4], vg[4];
#pragma unroll
        for (int k = 0; k < 4; ++k) { const int i = it + k * c.gthreads; if (i < total) { const size_t o = (size_t)(i / ncg) * DRNN + (i % ncg) * 8; vh[k] = __builtin_nontemporal_load((const u32x4*)(HL + o)); va[k] = __builtin_nontemporal_load((const u32x4*)(AC + o)); vg[k] = __builtin_nontemporal_load((const u32x4*)(GATE + o)); } }
#pragma unroll
        for (int k = 0; k < 4; ++k) { const int i = it + k * c.gthreads; if (i < total) {
            const int row = i / ncg, ch = (i % ncg) * 8; const size_t o = (size_t)row * DRNN + ch;
            f32x4 c0 = (f32x4){0.f, 0.f, 0.f, 0.f}, c1 = c0;
            if (row < RT) { const float* cp = CARRY + (size_t)(row >> 7) * DRNN + ch; c0 = *(const f32x4*)cp; c1 = *(const f32x4*)(cp + 4); }
            f32x4 h0, h1, a0, a1, g0, g1; unpack8(vh[k], h0, h1); unpack8(va[k], a0, a1); unpack8(vg[k], g0, g1);
            *(u32x4*)(Y + o) = pack8((h0 + a0 * c0) * g0, (h1 + a1 * c1) * g1); } }
    }
}
__device__ __forceinline__ void scan_carry(const float* AGGA, const float* AGGH, float* CARRY) {
    const Ctx c = mkctx();
    const int idx = c.gtid;
    if (idx >= NBATCH * DRNN * 16) return;
    const int seg = idx & 15, ch = (idx >> 4) % DRNN, b = (idx >> 4) / DRNN;
    const int G0 = 128 * b + 8 * seg;
    float a[8], h[8];
#pragma unroll
    for (int i = 0; i < 8; ++i) { a[i] = AGGA[(size_t)(G0 + i) * DRNN + ch]; h[i] = AGGH[(size_t)(G0 + i) * DRNN + ch]; }
    float A = 1.f, H = 0.f;
#pragma unroll
    for (int i = 0; i < 8; ++i) { H = a[i] * H + h[i]; A = a[i] * A; }
#pragma unroll
    for (int d = 1; d < 16; d <<= 1) {
        const float Ap = __shfl_up(A, d, 16), Hp = __shfl_up(H, d, 16);
        if (seg >= d) { H = A * Hp + H; A = A * Ap; }
    }
    float Ae = __shfl_up(A, 1, 16), He = __shfl_up(H, 1, 16);
    if (seg == 0) { Ae = 1.f; He = 0.f; }
    float cy = He + Ae * AGGH[(size_t)256 * DRNN + ch];
#pragma unroll
    for (int i = 0; i < 8; ++i) { CARRY[(size_t)(G0 + i) * DRNN + ch] = cy; cy = a[i] * cy + h[i]; }
}

__device__ __forceinline__ void final_norm(float* out, const bf16_t* HB, const float* SS, const float* gfin) {
    const Ctx c = mkctx();
    const int total = RT * (D / 8);
    for (int it = c.gtid; it < total; it += 4 * c.gthreads) {
        u32x4 v[4]; float rs[4];
#pragma unroll
        for (int k = 0; k < 4; ++k) { const int i = it + k * c.gthreads; const int row = i >> 7, col = (i & 127) * 8;
            if (i < total) { v[k] = *(const u32x4*)(HB + (size_t)row * D + col); rs[k] = SS[row]; } }
#pragma unroll
        for (int k = 0; k < 4; ++k) { const int i = it + k * c.gthreads; const int row = i >> 7, col = (i & 127) * 8;
            if (i < total) { f32x4 a, b; unpack8(v[k], a, b); const float r_ = rs_from_ss(rs[k]);
                *(f32x4*)(out + (size_t)row * D + col) = a * r_ * *(const f32x4*)(gfin + col); *(f32x4*)(out + (size_t)row * D + col + 4) = b * r_ * *(const f32x4*)(gfin + col + 4); } }
    }
}

#define XB_TMO      128
#define XB_XCNT(j)  (256  + 64 * (j))
#define XB_XSUB(j)  (1280 + 64 * (j))
#define XB_XGEN(j)  (2304 + 64 * (j))
#define XB_TOP      3328
#define XB_TOPGEN   3392
#define XCD_BAR_WORDS 3456
#define XB_SPIN_CAP (1u << 18)
__device__ __forceinline__ unsigned xb_ld(unsigned* p)              { return __hip_atomic_load(p, __ATOMIC_RELAXED, __HIP_MEMORY_SCOPE_AGENT); }
__device__ __forceinline__ unsigned xb_add(unsigned* p, unsigned v) { return __hip_atomic_fetch_add(p, v, __ATOMIC_RELAXED, __HIP_MEMORY_SCOPE_AGENT); }
__device__ __forceinline__ unsigned xb_xcc_id() { return (unsigned)__builtin_amdgcn_s_getreg((3 << 11) | 20) & 0xFu; }
#define XB_SPIN(cond, bar) do { unsigned _sp = 0; while (cond) { __builtin_amdgcn_s_sleep(1); \
    if ((++_sp & 255u) == 0u) { if (xb_ld(&(bar)[XB_TMO])) break; if (_sp > XB_SPIN_CAP) { atomicAdd(&(bar)[XB_TMO], 1u); break; } } } } while (0)
struct XcdBarrier { unsigned* bar; unsigned x; volatile LAS unsigned* st; };
__device__ __forceinline__ XcdBarrier xcd_barrier_post(unsigned* bar, volatile LAS unsigned* st) {
    XcdBarrier b; b.bar = bar; b.x = xb_xcc_id(); b.st = st;
    if (threadIdx.x == 0) (void)xb_add(&bar[XB_XCNT(b.x)], 1u);
    return b;
}
__device__ __forceinline__ void xcd_barrier_complete(unsigned* bar, unsigned x, unsigned& nloc, unsigned& nx) {
    const unsigned G = gridDim.x * gridDim.y * gridDim.z;
    unsigned sum, cnt, mine, sp = 0u;
    for (;;) {
        sum = 0u; cnt = 0u; mine = 0u;
#pragma unroll
        for (unsigned j = 0; j < 16; ++j) { const unsigned c = xb_ld(&bar[XB_XCNT(j)]); sum += c; cnt += (c > 0u) ? 1u : 0u; mine = (j == x) ? c : mine; }
        if (sum == G) break;
        __builtin_amdgcn_s_sleep(1);
        if ((++sp & 255u) == 0u) { if (xb_ld(&bar[XB_TMO])) break; if (sp > XB_SPIN_CAP) { atomicAdd(&bar[XB_TMO], 1u); break; } }
    }
    nloc = mine > 0u ? mine : 1u; nx = cnt > 0u ? cnt : 1u;
}
__device__ __forceinline__ void xcd_barrier(const XcdBarrier& b) {
    asm volatile("s_waitcnt vmcnt(0)" ::: "memory");
    __syncthreads();
    if (threadIdx.x == 0) {
        unsigned* bar = b.bar;
        __builtin_amdgcn_s_waitcnt(0);
        unsigned nloc = b.st[0], nx = b.st[1];
        if (nloc == 0u) { xcd_barrier_complete(bar, b.x, nloc, nx); b.st[0] = nloc; b.st[1] = nx; }
        const unsigned old = xb_add(&bar[XB_XSUB(b.x)], 1u);
        const unsigned gen = old / nloc;
        if (old + 1u == (gen + 1u) * nloc) {
            __builtin_amdgcn_fence(__ATOMIC_RELEASE, "agent");
            asm volatile("s_waitcnt vmcnt(0)" ::: "memory");
            const unsigned og = xb_add(&bar[XB_TOP], 1u);
            const unsigned tg = og / nx;
            if (og + 1u == (tg + 1u) * nx) xb_add(&bar[XB_TOPGEN], 1u);
            else XB_SPIN(xb_ld(&bar[XB_TOPGEN]) == tg, bar);
            __builtin_amdgcn_fence(__ATOMIC_ACQUIRE, "agent");
            xb_add(&bar[XB_XGEN(b.x)], 1u);
            asm volatile("s_waitcnt vmcnt(0)" ::: "memory");
        } else {
            XB_SPIN(xb_ld(&bar[XB_XGEN(b.x)]) == gen, bar);
            __builtin_amdgcn_fence(__ATOMIC_ACQUIRE, "agent");
            asm volatile("s_waitcnt vmcnt(0)" ::: "memory");
        }
    }
    __syncthreads();
}

constexpr int LDS_BYTES = 147456;
#define GSYNC() xcd_barrier(xbar)

__global__ void __launch_bounds__(NTHREADS) fwd_megakernel(Params p) {
    extern __shared__ __attribute__((aligned(16))) unsigned char lds_raw[];
    LAS unsigned char* lds = (LAS unsigned char*)lds_raw;
    cg::grid_group grid = cg::this_grid();
    const int NG = gridDim.x;
    if (threadIdx.x < 2) ((volatile LAS unsigned*)(lds + 131072 + 512))[threadIdx.x] = 0u;
    __syncthreads();
    const XcdBarrier xbar = xcd_barrier_post((unsigned*)(p.ws + WS_BAR), (volatile LAS unsigned*)(lds + 131072 + 512));
    unsigned char* ws = p.ws;
    float* SS = (float*)(ws + WS_SS);
    float* SP = (float*)(ws + WS_SP);
    float* AGGA = (float*)(ws + WS_AGGA); float* AGGH = (float*)(ws + WS_AGGH); float* CARRY = (float*)(ws + WS_CARRY);
    float* PRE = (float*)(ws + WS_PRE);
    bf16_t* W = (bf16_t*)(ws + WS_W);
    bf16_t* HB = (bf16_t*)(ws + WS_HB);
    bf16_t* S0 = (bf16_t*)(ws + WS_SCR); bf16_t* S1 = (bf16_t*)(ws + WS_SCR + SCR_STRIDE); bf16_t* S2 = (bf16_t*)(ws + WS_SCR + 2 * SCR_STRIDE); bf16_t* S3 = (bf16_t*)(ws + WS_SCR + 3 * SCR_STRIDE);
    pg8::StaticOrder S;

    grid.sync();
    prep_phase(p, lds);
    GSYNC();
    { bf16_t* CV = S0; bf16_t* Bg = S1; bf16_t* Z = S2;
      { pg8::Gemm g{HB, W + OW1, D, 1024, 0}; S.init(128, 12, NG, blockIdx.x); EpiScIn E{SS, CV, Bg};
        pg8::gemm_phase(lds, g, S, E); pg8::mini_gemm(lds, g, 12, E); }
      GSYNC();
      conv_pass<3, true, false>(CV, Bg, Z, p.in[I_SCCONV], nullptr, D);
      GSYNC();
      { pg8::Gemm g{Z, W + OW2, D, 1024, 0}; S.init(128, 4, NG, blockIdx.x); EpiResid E{HB, SS + SS_STRIDE};
        pg8::gemm_phase(lds, g, S, E); pg8::mini_gemm(lds, g, 4, E); }
      GSYNC(); }
    { bf16_t* ACT = S0;
      { pg8::Gemm g{HB, W + OW3, D, 1024, 0}; S.init(128, 22, NG, blockIdx.x); EpiFfnUp E{SS + SS_STRIDE, (const float*)(ws + WS_FCW), ACT, PRE};
        pg8::gemm_phase(lds, g, S, E); pg8::mini_gemm(lds, g, 22, E); }
      GSYNC();
      ffn_fixup(PRE, p.in[I_FFCONV], ACT);
      GSYNC();
      { pg8::Gemm g{ACT, W + OW4, DFF, 2816, 0}; S.init(128, 4, NG, blockIdx.x); EpiResid E{HB, SS + 2 * SS_STRIDE};
        pg8::gemm_phase(lds, g, S, E); pg8::mini_gemm(lds, g, 4, E); }
      GSYNC(); }
    { bf16_t* GATE = S0; bf16_t* HL = S1; bf16_t* U = S2; bf16_t* Y = S2; bf16_t* AC = S3;
      { pg8::Gemm g{HB, W + OW5, D, 1024, 0}; S.init(128, 10, NG, blockIdx.x); EpiRgIn E{SS + 2 * SS_STRIDE, p.in[I_RGCONV], p.in[I_RGCONVB], GATE, U, PRE};
        pg8::gemm_phase(lds, g, S, E); pg8::mini_gemm(lds, g, 10, E); }
      GSYNC();
      rg_fixup(PRE, p.in[I_RGCONV], p.in[I_RGCONVB], U);
      GSYNC();
      { pg8::Gemm g{U, W + OW6, DRNN, 128, 128}; S.init(128, 10, NG, blockIdx.x); EpiRgGate E{U, p.in[I_RGBA], p.in[I_RGBX], SP, HL, AC, AGGA, AGGH};
        pg8::gemm_phase(lds, g, S, E); pg8::mini_gemm(lds, g, 10, E); }
      GSYNC();
      scan_carry(AGGA, AGGH, CARRY);
      GSYNC();
      scan_apply(HL, AC, GATE, Y, CARRY);
      GSYNC();
      { pg8::Gemm g{Y, W + OW7, DRNN, 1280, 0}; S.init(128, 4, NG, blockIdx.x); EpiResid E{HB, SS + 3 * SS_STRIDE};
        pg8::gemm_phase(lds, g, S, E); pg8::mini_gemm(lds, g, 4, E); }
      GSYNC(); }
    { bf16_t* ACT = S0;
      { pg8::Gemm g{HB, W + OW8, D, 1024, 0}; S.init(128, 22, NG, blockIdx.x); EpiFfnUp E{SS + 3 * SS_STRIDE, (const float*)(ws + WS_FCW) + 3 * 2 * DFF, ACT, PRE};
        pg8::gemm_phase(lds, g, S, E); pg8::mini_gemm(lds, g, 22, E); }
      GSYNC();
      ffn_fixup(PRE, p.in[I_FFCONV] + 3 * 2 * DFF, ACT);
      GSYNC();
      { pg8::Gemm g{ACT, W + OW9, DFF, 2816, 0}; S.init(128, 4, NG, blockIdx.x); EpiResidFinal E{HB, SS + 4 * SS_STRIDE, (unsigned*)(ws + WS_CNT), p.in[I_FNG], p.out};
        pg8::gemm_phase(lds, g, S, E); } }
}

extern "C" void kernel_launch(void* const* d_in, const int* in_sizes, int n_in, void* d_out, int out_size, void* d_ws, size_t ws_size, hipStream_t stream) {
    static int grid = 0;
    if (grid == 0) {
        if (n_in != 20 || ws_size < WS_NEED) { fprintf(stderr, "kernel_launch: unexpected n_in %d / ws_size %zu\n", n_in, ws_size); grid = -1; return; }
        int dev = 0, cus = 0, per_cu = 0;
        hipGetDevice(&dev);
        hipDeviceGetAttribute(&cus, hipDeviceAttributeMultiprocessorCount, dev);
        if (hipFuncSetAttribute((const void*)fwd_megakernel, hipFuncAttributeMaxDynamicSharedMemorySize, LDS_BYTES) != hipSuccess) { fprintf(stderr, "kernel_launch: hipFuncSetAttribute failed\n"); grid = -1; return; }
        if (hipOccupancyMaxActiveBlocksPerMultiprocessor(&per_cu, (const void*)fwd_megakernel, NTHREADS, LDS_BYTES) != hipSuccess || per_cu < 1) { fprintf(stderr, "kernel_launch: occupancy query says %d\n", per_cu); grid = -1; return; }
        grid = cus;
    }
    if (grid < 0) return;
    Params p{};
    for (int i = 0; i < 20; ++i) p.in[i] = (const float*)d_in[i];
    p.out = (float*)d_out; p.ws = (unsigned char*)d_ws;
    if (hipMemsetAsync((char*)d_ws + WS_BAR, 0, (WS_CNT - WS_BAR) + 128 * 64 * 4, stream) != hipSuccess) { fprintf(stderr, "kernel_launch: memset failed\n"); return; }
    void* args[] = {&p};
    hipError_t e = hipLaunchCooperativeKernel((const void*)fwd_megakernel, dim3(grid), dim3(NTHREADS), args, LDS_BYTES, stream);
    if (e != hipSuccess) fprintf(stderr, "cooperative launch failed: %s (grid %d)\n", hipGetErrorString(e), grid);
}
```
